# Optimizing an MI355X kernel written in HIP

```python
import math
import jax, jax.numpy as jnp
from jax import lax
import numpy as np

D_MODEL = 2048
BATCH = 1
SEQ = 16384
DEPTH = 1

GRID_W = 64
CTX_LEN = 256
MIX_W = D_MODEL
ATTN_W = MIX_W // 2
HEAD_DIM = 128
N_HEADS = ATTN_W // HEAD_DIM
N_KV_HEADS = 2
GQA_GROUP = N_HEADS // N_KV_HEADS
KV_W = N_KV_HEADS * HEAD_DIM
ATTN_SCALE = HEAD_DIM ** -0.5
ROPE_THETA = 10000.0
ROPE_AXIS_DIM = HEAD_DIM // 2
Q_BLOCK = 128
RG_W = MIX_W - ATTN_W
RG_HEADS = 8
RG_HD = RG_W // RG_HEADS
CONV_W = 4
RG_C = 8.0
PROJ_W = ATTN_W + 2 * KV_W + 2 * RG_W
N_EXPERTS = 64
N_GROUPS = 8
TOPK_GROUPS = 4
TOP_K = 8
EXPERT_FF = 512
SHARED_FF = 512
ROUTED_SCALE = 2.5
MOE_BLOCK = 128
NORM_EPS = 1e-6
DEEPNORM_ALPHA = (2.0 * DEPTH) ** 0.25
DEEPNORM_BETA = (8.0 * DEPTH) ** -0.25

kernel_name = "hybrid_attn_rglru_moe_dit_layer"


def _layer_norm(x, g, b):
    xf = x.astype(jnp.float32)
    mu = jnp.mean(xf, axis=-1, keepdims=True)
    var = jnp.mean(jnp.square(xf - mu), axis=-1, keepdims=True)
    y = (xf - mu) * lax.rsqrt(var + NORM_EPS) * g.astype(jnp.float32) + b.astype(jnp.float32)
    return y.astype(x.dtype)


def _rms_norm(x, g):
    xf = x.astype(jnp.float32)
    y = xf * lax.rsqrt(jnp.mean(jnp.square(xf), axis=-1, keepdims=True) + NORM_EPS)
    return (y * g.astype(jnp.float32)).astype(x.dtype)


def _rope_axis(x, pos):
    half = ROPE_AXIS_DIM // 2
    inv_freq = ROPE_THETA ** (-jnp.arange(half, dtype=jnp.float32) / half)
    ang = pos.astype(jnp.float32)[:, None] * inv_freq[None, :]
    cos = jnp.concatenate([jnp.cos(ang), jnp.cos(ang)], axis=-1)[None, :, None, :]
    sin = jnp.concatenate([jnp.sin(ang), jnp.sin(ang)], axis=-1)[None, :, None, :]
    xf = x.astype(jnp.float32)
    rot = jnp.concatenate([-xf[..., half:], xf[..., :half]], axis=-1)
    return (xf * cos + rot * sin).astype(x.dtype)


def _rope_2d(x, row, col):
    return jnp.concatenate([_rope_axis(x[..., :ROPE_AXIS_DIM], row),
                            _rope_axis(x[..., ROPE_AXIS_DIM:], col)], axis=-1)


def _block_attention(q, k, v):
    B, Sq = q.shape[0], q.shape[1]
    nblk = Sq // Q_BLOCK
    qb = q.reshape(B, nblk, Q_BLOCK, N_KV_HEADS, GQA_GROUP, HEAD_DIM).transpose(1, 0, 2, 3, 4, 5)

    def one_block(qblk):
        s = jnp.einsum('bqkgd,bskd->bkgqs', qblk, k).astype(jnp.float32) * ATTN_SCALE
        p = jax.nn.softmax(s, axis=-1)
        return jnp.einsum('bkgqs,bskd->bqkgd', p.astype(v.dtype), v)

    o = lax.map(one_block, qb)
    return o.transpose(1, 0, 2, 3, 4, 5).reshape(B, Sq, ATTN_W)


def _centred_dwconv(x, w, b):
    S = x.shape[1]
    left = CONV_W // 2
    right = CONV_W - 1 - left
    xp = jnp.pad(x, ((0, 0), (left, right), (0, 0)))
    out = b
    for j in range(CONV_W):
        out = out + w[j] * xp[:, j:j + S]
    return out


def _rglru_coeffs(xc, w_a, b_a, w_x, b_x, lam):
    B, S, _ = xc.shape
    xh = xc.reshape(B, S, RG_HEADS, RG_HD)
    r = jax.nn.sigmoid((jnp.einsum('bshi,hij->bshj', xh, w_a).reshape(B, S, RG_W) + b_a).astype(jnp.float32))
    i = jax.nn.sigmoid((jnp.einsum('bshi,hij->bshj', xh, w_x).reshape(B, S, RG_W) + b_x).astype(jnp.float32))
    log_a = RG_C * r * jax.nn.log_sigmoid(lam.astype(jnp.float32))
    a = jnp.exp(log_a)
    b = jnp.sqrt(-jnp.expm1(2.0 * log_a)) * (i * xc.astype(jnp.float32))
    return a, b


def _combine(left, right):
    a1, b1 = left
    a2, b2 = right
    return a1 * a2, a2 * b1 + b2


def _linear_scan(a, b, h0, reverse):
    a_cum, h = lax.associative_scan(_combine, (a, b), axis=1, reverse=reverse)
    return h + a_cum * h0[:, None, :]


def _split_proj(p):
    B, S = p.shape[0], p.shape[1]
    q, k, v, xr, yr = jnp.split(p, [ATTN_W, ATTN_W + KV_W, ATTN_W + 2 * KV_W,
                                   ATTN_W + 2 * KV_W + RG_W], axis=-1)
    return (q.reshape(B, S, N_HEADS, HEAD_DIM), k.reshape(B, S, N_KV_HEADS, HEAD_DIM),
            v.reshape(B, S, N_KV_HEADS, HEAD_DIM), xr, yr)


def _token_mixer(u_lat, u_ctx, row, col, w_in, q_norm, k_norm, conv_w, conv_b,
                 rg_wa, rg_ba, rg_wx, rg_bx, rg_lam, w_out, with_ctx_out):
    q_l, k_l, v_l, xr_l, yr_l = _split_proj(u_lat @ w_in)
    q_c, k_c, v_c, xr_c, yr_c = _split_proj(u_ctx @ w_in)
    q_l = _rope_2d(_rms_norm(q_l, q_norm), row, col)
    k_l = _rope_2d(_rms_norm(k_l, k_norm), row, col)
    k_c = _rms_norm(k_c, k_norm)
    k_all = jnp.concatenate([k_c, k_l], axis=1)
    v_all = jnp.concatenate([v_c, v_l], axis=1)
    attn_l = _block_attention(q_l, k_all, v_all)
    xc_c = _centred_dwconv(xr_c, conv_w, conv_b)
    xc_l = _centred_dwconv(xr_l, conv_w, conv_b)
    B = u_lat.shape[0]
    zero_state = jnp.zeros((B, RG_W), jnp.float32)
    rg_l = jnp.zeros(xc_l.shape, jnp.float32)
    ctx_scans = []
    for d, reverse in enumerate((False, True)):
        a_c, b_c = _rglru_coeffs(xc_c, rg_wa[d], rg_ba[d], rg_wx[d], rg_bx[d], rg_lam[d])
        h_c = _linear_scan(a_c, b_c, zero_state, reverse)
        ctx_scans.append(h_c)
        h0 = h_c[:, 0] if reverse else h_c[:, -1]
        a_l, b_l = _rglru_coeffs(xc_l, rg_wa[d], rg_ba[d], rg_wx[d], rg_bx[d], rg_lam[d])
        rg_l = rg_l + _linear_scan(a_l, b_l, h0, reverse)
    rg_l = (rg_l * jax.nn.gelu(yr_l).astype(jnp.float32)).astype(u_lat.dtype)
    out_l = jnp.concatenate([attn_l, rg_l], axis=-1) @ w_out
    if not with_ctx_out:
        return out_l, None
    attn_c = _block_attention(_rms_norm(q_c, q_norm), k_c, v_c)
    rg_c = ((ctx_scans[0] + ctx_scans[1]) * jax.nn.gelu(yr_c).astype(jnp.float32)).astype(u_ctx.dtype)
    out_c = jnp.concatenate([attn_c, rg_c], axis=-1) @ w_out
    return out_l, out_c


def _swiglu(x, w1, w3, w2):
    return (jax.nn.silu(x @ w1) * (x @ w3)) @ w2


def _moe(h, w_router, e_bias, w_e1, w_e3, w_e2, w_s1, w_s3, w_s2):
    n, d = h.shape
    scores = jax.nn.sigmoid((h @ w_router).astype(jnp.float32))
    biased = scores + e_bias.astype(jnp.float32)
    per_group = N_EXPERTS // N_GROUPS
    group_score = lax.top_k(biased.reshape(n, N_GROUPS, per_group), 2)[0].sum(-1)
    _, top_groups = lax.top_k(group_score, TOPK_GROUPS)
    group_mask = jax.nn.one_hot(top_groups, N_GROUPS, dtype=jnp.float32).sum(1) > 0
    expert_mask = jnp.repeat(group_mask, per_group, axis=1)
    _, idx = lax.top_k(jnp.where(expert_mask, biased, -jnp.inf), TOP_K)
    wts = jnp.take_along_axis(scores, idx, axis=-1)
    wts = wts / jnp.sum(wts, axis=-1, keepdims=True) * ROUTED_SCALE
    nk = n * TOP_K
    flat_e = idx.reshape(nk)
    flat_t = jnp.repeat(jnp.arange(n, dtype=jnp.int32), TOP_K)
    flat_w = wts.reshape(nk)
    order = jnp.argsort(flat_e)
    e_s, t_s, w_s = flat_e[order], flat_t[order], flat_w[order]
    counts = jnp.bincount(flat_e, length=N_EXPERTS)
    start = jnp.cumsum(counts) - counts
    padded = (counts + MOE_BLOCK - 1) // MOE_BLOCK * MOE_BLOCK
    pad_end = jnp.cumsum(padded)
    pad_start = pad_end - padded
    dest = pad_start[e_s] + jnp.arange(nk, dtype=jnp.int32) - start[e_s]
    n_blocks = -(-nk // MOE_BLOCK) + N_EXPERTS
    slot_tok = jnp.full((n_blocks * MOE_BLOCK,), n, jnp.int32).at[dest].set(t_s)
    slot_w = jnp.zeros((n_blocks * MOE_BLOCK,), jnp.float32).at[dest].set(w_s)
    blk_e = jnp.minimum(jnp.searchsorted(pad_end, jnp.arange(n_blocks, dtype=jnp.int32) * MOE_BLOCK,
                                         side='right'), N_EXPERTS - 1)
    h_pad = jnp.concatenate([h, jnp.zeros((1, d), h.dtype)], axis=0)

    def body(acc, blk):
        tok, wt, e = blk
        xb = h_pad[tok]
        yb = _swiglu(xb, w_e1[e], w_e3[e], w_e2[e]) * wt[:, None].astype(h.dtype)
        return acc.at[tok].add(yb), None

    acc, _ = lax.scan(body, jnp.zeros((n + 1, d), h.dtype),
                      (slot_tok.reshape(n_blocks, MOE_BLOCK), slot_w.reshape(n_blocks, MOE_BLOCK), blk_e))
    return acc[:n] + _swiglu(h, w_s1, w_s3, w_s2)


def setup_inputs(seed: int = 0) -> dict:
    key = jax.random.key(seed)
    ks = jax.random.split(key, 32)
    f32 = jnp.float32
    L, D = DEPTH, D_MODEL

    def nrm(k, shape, scale):
        return jax.random.normal(k, shape, f32) * scale

    u = jax.random.uniform(ks[13], (L, 2, RG_W), f32, 0.9, 0.999)
    a0 = u ** (1.0 / RG_C)
    return {
        "x": nrm(ks[0], (BATCH, SEQ, D), 1.0),
        "c": nrm(ks[1], (BATCH, D), 1.0),
        "ctx": nrm(ks[2], (BATCH, CTX_LEN, D), 1.0),
        "c_ctx": nrm(ks[3], (D,), 1.0),
        "w_mod": nrm(ks[4], (L, D, 6 * D), 0.5 * D ** -0.5),
        "b_mod": nrm(ks[5], (L, 6 * D), 0.02),
        "w_in": nrm(ks[6], (L, D, PROJ_W), D ** -0.5),
        "q_norm": 1.0 + nrm(ks[7], (L, HEAD_DIM), 0.02),
        "k_norm": 1.0 + nrm(ks[8], (L, HEAD_DIM), 0.02),
        "conv_w": nrm(ks[9], (L, CONV_W, RG_W), CONV_W ** -0.5),
        "conv_b": nrm(ks[10], (L, RG_W), 0.02),
        "rg_wa": nrm(ks[11], (L, 2, RG_HEADS, RG_HD, RG_HD), RG_HD ** -0.5),
        "rg_ba": nrm(ks[12], (L, 2, RG_W), 0.02),
        "rg_wx": nrm(ks[14], (L, 2, RG_HEADS, RG_HD, RG_HD), RG_HD ** -0.5),
        "rg_bx": nrm(ks[15], (L, 2, RG_W), 0.02),
        "rg_lam": jnp.log(a0) - jnp.log1p(-a0),
        "w_out": nrm(ks[16], (L, MIX_W, D), MIX_W ** -0.5 * DEEPNORM_BETA),
        "ln1_g": 1.0 + nrm(ks[17], (L, D), 0.02),
        "ln1_b": nrm(ks[18], (L, D), 0.02),
        "w_router": nrm(ks[19], (L, D, N_EXPERTS), D ** -0.5),
        "e_bias": nrm(ks[20], (L, N_EXPERTS), 0.01),
        "w_e1": nrm(ks[21], (L, N_EXPERTS, D, EXPERT_FF), D ** -0.5),
        "w_e3": nrm(ks[22], (L, N_EXPERTS, D, EXPERT_FF), D ** -0.5),
        "w_e2": nrm(ks[23], (L, N_EXPERTS, EXPERT_FF, D), EXPERT_FF ** -0.5 * DEEPNORM_BETA),
        "w_s1": nrm(ks[24], (L, D, SHARED_FF), D ** -0.5),
        "w_s3": nrm(ks[25], (L, D, SHARED_FF), D ** -0.5),
        "w_s2": nrm(ks[26], (L, SHARED_FF, D), SHARED_FF ** -0.5 * DEEPNORM_BETA),
        "ln2_g": 1.0 + nrm(ks[27], (L, D), 0.02),
        "ln2_b": nrm(ks[28], (L, D), 0.02),
    }


def reference(x, c, ctx, c_ctx, w_mod, b_mod, w_in, q_norm, k_norm, conv_w, conv_b,
              rg_wa, rg_ba, rg_wx, rg_bx, rg_lam, w_out, ln1_g, ln1_b, w_router, e_bias,
              w_e1, w_e3, w_e2, w_s1, w_s3, w_s2, ln2_g, ln2_b):
    B, S, D = x.shape
    n_ctx = ctx.shape[1]
    rows = S // GRID_W
    row = jnp.repeat(jnp.arange(rows, dtype=jnp.int32), GRID_W)
    col = jnp.tile(jnp.arange(GRID_W, dtype=jnp.int32), rows)
    h_lat, h_ctx = x, ctx
    for l in range(DEPTH):
        update_ctx = l + 1 < DEPTH
        mod_lat = jax.nn.silu(c) @ w_mod[l] + b_mod[l]
        mod_ctx = jax.nn.silu(c_ctx) @ w_mod[l] + b_mod[l]
        sh1, sc1, g1, sh2, sc2, g2 = jnp.split(mod_lat[:, None, :], 6, axis=-1)
        csh1, csc1, cg1, csh2, csc2, cg2 = jnp.split(mod_ctx, 6, axis=-1)
        u_lat = h_lat * (1.0 + sc1) + sh1
        u_ctx = h_ctx * (1.0 + csc1) + csh1
        mix_lat, mix_ctx = _token_mixer(u_lat, u_ctx, row, col, w_in[l], q_norm[l], k_norm[l],
                                        conv_w[l], conv_b[l], rg_wa[l], rg_ba[l], rg_wx[l],
                                        rg_bx[l], rg_lam[l], w_out[l], update_ctx)
        h_lat = _layer_norm(DEEPNORM_ALPHA * h_lat + g1 * mix_lat, ln1_g[l], ln1_b[l])
        v_lat = (h_lat * (1.0 + sc2) + sh2).reshape(B * S, D)
        if update_ctx:
            h_ctx = _layer_norm(DEEPNORM_ALPHA * h_ctx + cg1 * mix_ctx, ln1_g[l], ln1_b[l])
            v_ctx = (h_ctx * (1.0 + csc2) + csh2).reshape(B * n_ctx, D)
            ff = _moe(jnp.concatenate([v_ctx, v_lat], axis=0), w_router[l], e_bias[l],
                      w_e1[l], w_e3[l], w_e2[l], w_s1[l], w_s3[l], w_s2[l])
            ff_ctx = ff[:B * n_ctx].reshape(B, n_ctx, D)
            ff_lat = ff[B * n_ctx:].reshape(B, S, D)
            h_ctx = _layer_norm(DEEPNORM_ALPHA * h_ctx + cg2 * ff_ctx, ln2_g[l], ln2_b[l])
        else:
            ff_lat = _moe(v_lat, w_router[l], e_bias[l], w_e1[l], w_e3[l], w_e2[l],
                          w_s1[l], w_s3[l], w_s2[l]).reshape(B, S, D)
        h_lat = _layer_norm(DEEPNORM_ALPHA * h_lat + g2 * ff_lat, ln2_g[l], ln2_b[l])
    return h_lat
```

```cpp
#include <hip/hip_runtime.h>
#include <cstdio>
#include <cstdint>
#include <cstddef>

#ifndef MK_N_LAUNCHES
#define MK_N_LAUNCHES 1
#endif
#ifndef ATTN_FP8
#define ATTN_FP8 1
#endif

constexpr int DM = 2048, SEQ = 16384, CTXL = 256, MTOT = SEQ + CTXL;
constexpr int PROJ_W = 3584, ATTN_W = 1024, KV_W = 256, RG_W = 1024, HD = 128, NHEAD = 8, NKV = 2;
constexpr int COL_Q = 0, COL_K = 1024, COL_V = 1280, COL_XR = 1536, COL_YR = 2560;
constexpr int NEXP = 64, TOPK = 8, EFF = 512, NEXP1 = NEXP + 1;
constexpr int GRIDW = 64;
constexpr float NORM_EPS = 1e-6f;
constexpr float DN_ALPHA = 1.189207115002721f;
constexpr int RG_CH = 32, NCH_CTX = CTXL / RG_CH, NCH_LAT = SEQ / RG_CH, NCH = NCH_CTX + NCH_LAT;
constexpr int MAX_SLOTS = SEQ * TOPK + NEXP * 256 + SEQ;
constexpr int MAX_TILES = MAX_SLOTS / 256;
constexpr float Y_SCALE = 32.f;
constexpr float W_SCALE = 64.f, V_SCALE = 8.f, H_SCALE = 8.f;

namespace pg8 {
#define PG8_LAS __attribute__((address_space(3)))
typedef unsigned short bf16_t;
typedef short bf16x8 __attribute__((ext_vector_type(8)));
typedef float f32x4 __attribute__((ext_vector_type(4)));
typedef unsigned u32x4 __attribute__((ext_vector_type(4)));
constexpr int BM = 256, BK = 64, HALF = 128, HTB = HALF * BK * 2, STAGE_BYTES = 8 * HTB, NXCD = 8, WGM = 8;

__host__ __device__ __forceinline__ int lds_byte(int r, int c) { const int st = (r >> 4) * 2 + (c >> 5), rr = r & 15, cc = c & 31, ob = rr * 64 + cc * 2; return st * 1024 + (ob ^ (((ob >> 9) & 1) << 5)); }
__host__ __device__ __forceinline__ void stage_rc(int b, int& R, int& C) { const int st = b / 1024, sb = b % 1024, swz = sb ^ (((sb >> 9) & 1) << 5); R = (st >> 1) * 16 + swz / 64; C = (st & 1) * 32 + (swz % 64) / 2; }
__host__ __device__ __forceinline__ int perm32(int rho) { const int n = rho >> 4, i = rho & 15; return 8 * (i >> 2) + 4 * n + (i & 3); }

struct Unit { int pm, pn, e; };
struct Gemm { const bf16_t* A; const bf16_t* Bt; int K; long bstride; const PG8_LAS int* gather; };

__device__ __forceinline__ int ld_i32_agent(const int* p) { return __hip_atomic_load(p, __ATOMIC_RELAXED, __HIP_MEMORY_SCOPE_AGENT); }

__device__ __forceinline__ int xcd_remap(int L, int nwg) { const int q = nwg / NXCD, r = nwg % NXCD, xcd = L % NXCD, off = L / NXCD; return (xcd < r ? xcd * (q + 1) : r * (q + 1) + (xcd - r) * q) + off; }

struct StaticOrder {
    int nM, nN, nwg, G, c;
    __device__ void init(int M, int N, int G_, int c_) { nM = M / BM; nN = N / BM; nwg = nM * nN; G = G_; c = c_; }
    __device__ bool next(int i, Unit& u) const {
        const long L = (long)i * G + c; if (L >= nwg) return false;
        const int wgid = xcd_remap((int)L, nwg);
        const int nig = WGM * nN, gid = wgid / nig, fm = gid * WGM, gsz = (nM - fm) < WGM ? (nM - fm) : WGM;
        u.pm = fm + ((wgid % nig) % gsz); u.pn = (wgid % nig) / gsz; u.e = 0; return true;
    }
};
struct GroupedOrder {
    const PG8_LAS int* ut; int n;
    __device__ bool next(int i, Unit& u) const {
        if (i >= n) return false;
        u.pm = __builtin_amdgcn_readfirstlane(ut[4 * i]); u.pn = __builtin_amdgcn_readfirstlane(ut[4 * i + 1]); u.e = __builtin_amdgcn_readfirstlane(ut[4 * i + 2]); return true;
    }
};

__device__ __forceinline__ unsigned cvt_pk_bf16(float lo, float hi) { unsigned r; asm volatile("v_cvt_pk_bf16_f32 %0, %1, %2" : "=v"(r) : "v"(lo), "v"(hi)); return r; }

struct EpiBf16 {
    static constexpr bool PERM = true; static constexpr bool PERM64 = false; static constexpr int NSTORE = 16;
    bf16_t* O; int ldc; float scale;
    __device__ __forceinline__ void operator()(const f32x4 (&acc)[2][2][4][2], const Unit& u, int wr, int wc, int fr, int fq) const {
        const int row0 = u.pm * BM + wr * 64 + fr, col0 = u.pn * BM + wc * 32 + 8 * fq;
#pragma unroll
        for (int ai = 0; ai < 2; ++ai)
#pragma unroll
            for (int m = 0; m < 4; ++m) { bf16_t* rowp = O + (size_t)(row0 + ai * HALF + m * 16) * ldc + col0;
#pragma unroll
                for (int bj = 0; bj < 2; ++bj) { const f32x4 v0 = acc[ai][bj][m][0] * scale, v1 = acc[ai][bj][m][1] * scale;
                    u32x4 w; w.x = cvt_pk_bf16(v0[0], v0[1]); w.y = cvt_pk_bf16(v0[2], v0[3]); w.z = cvt_pk_bf16(v1[0], v1[1]); w.w = cvt_pk_bf16(v1[2], v1[3]);
                    *(u32x4*)(rowp + bj * HALF) = w; } }
    }
};
struct EpiFp8 {
    static constexpr bool PERM = true; static constexpr bool PERM64 = true; static constexpr int NSTORE = 8;
    unsigned char* O; int ldc; float scale;
    __device__ __forceinline__ void operator()(const f32x4 (&acc)[2][2][4][2], const Unit& u, int wr, int wc, int fr, int fq) const;
};
struct EpiResid {
    static constexpr bool PERM = false; static constexpr bool PERM64 = false; static constexpr int NSTORE = 0;
    float* C; const float* X; const float* gate; int ldc; float alpha;
    __device__ __forceinline__ void operator()(const f32x4 (&acc)[2][2][4][2], const Unit& u, int wr, int wc, int fr, int fq) const {
        const int row0 = u.pm * BM + wr * 64 + fr, col0 = u.pn * BM + wc * 32 + 4 * fq;
        f32x4 gv[2][2];
#pragma unroll
        for (int bj = 0; bj < 2; ++bj)
#pragma unroll
            for (int n = 0; n < 2; ++n) gv[bj][n] = *(const f32x4*)(gate + col0 + bj * HALF + n * 16);
#pragma unroll
        for (int ai = 0; ai < 2; ++ai)
#pragma unroll
            for (int m = 0; m < 4; ++m) { const size_t ro = (size_t)(row0 + ai * HALF + m * 16) * ldc + col0;
#pragma unroll
                for (int bj = 0; bj < 2; ++bj)
#pragma unroll
                    for (int n = 0; n < 2; ++n) { const f32x4 xv = *(const f32x4*)(X + ro + bj * HALF + n * 16);
                        *(f32x4*)(C + ro + bj * HALF + n * 16) = xv * alpha + gv[bj][n] * acc[ai][bj][m][n]; } }
    }
};
__device__ __forceinline__ float silu_f(float x) { return x / (1.f + __expf(-x)); }
__device__ __forceinline__ unsigned pk4_fp8(float a, float b, float c, float d) {
    a = __builtin_amdgcn_fmed3f(a, -448.f, 448.f); b = __builtin_amdgcn_fmed3f(b, -448.f, 448.f); c = __builtin_amdgcn_fmed3f(c, -448.f, 448.f); d = __builtin_amdgcn_fmed3f(d, -448.f, 448.f);
    int w = 0; w = __builtin_amdgcn_cvt_pk_fp8_f32(a, b, w, false); w = __builtin_amdgcn_cvt_pk_fp8_f32(c, d, w, true); return (unsigned)w;
}
__device__ __forceinline__ void EpiFp8::operator()(const f32x4 (&acc)[2][2][4][2], const Unit& u, int wr, int wc, int fr, int fq) const {
    const int row0 = u.pm * BM + wr * 64 + fr, col0 = u.pn * BM + wc * 64 + 16 * fq;
#pragma unroll
    for (int ai = 0; ai < 2; ++ai)
#pragma unroll
        for (int m = 0; m < 4; ++m) { unsigned char* rowp = O + (size_t)(row0 + ai * HALF + m * 16) * ldc + col0;
            const f32x4 a0 = acc[ai][0][m][0] * scale, a1 = acc[ai][0][m][1] * scale, b0 = acc[ai][1][m][0] * scale, b1 = acc[ai][1][m][1] * scale;
            u32x4 o; o.x = pk4_fp8(a0[0], a0[1], a0[2], a0[3]); o.y = pk4_fp8(a1[0], a1[1], a1[2], a1[3]); o.z = pk4_fp8(b0[0], b0[1], b0[2], b0[3]); o.w = pk4_fp8(b1[0], b1[1], b1[2], b1[3]);
            *(u32x4*)rowp = o; }
}
struct EpiSwiGLU {
    static constexpr bool PERM = true; static constexpr bool PERM64 = false; static constexpr int NSTORE = 0;
    unsigned char* H; const float* w; float iscale, oscale;
    __device__ __forceinline__ void operator()(const f32x4 (&acc)[2][2][4][2], const Unit& u, int wr, int wc, int fr, int fq) const {
        const int row0 = u.pm * BM + wr * 64 + fr, col0 = u.pn * HALF + wc * 32 + 8 * fq;
        float wv[2][4];
#pragma unroll
        for (int ai = 0; ai < 2; ++ai)
#pragma unroll
            for (int m = 0; m < 4; ++m) wv[ai][m] = w[row0 + ai * HALF + m * 16] * oscale;
#pragma unroll
        for (int ai = 0; ai < 2; ++ai)
#pragma unroll
            for (int m = 0; m < 4; ++m) { unsigned char* rowp = H + (size_t)(row0 + ai * HALF + m * 16) * EFF + col0;
                f32x4 h0, h1;
#pragma unroll
                for (int j = 0; j < 4; ++j) { h0[j] = silu_f(acc[ai][0][m][0][j] * iscale) * (acc[ai][1][m][0][j] * iscale) * wv[ai][m]; h1[j] = silu_f(acc[ai][0][m][1][j] * iscale) * (acc[ai][1][m][1][j] * iscale) * wv[ai][m]; }
                typedef unsigned u32x2 __attribute__((ext_vector_type(2)));
                u32x2 o; o.x = pk4_fp8(h0[0], h0[1], h0[2], h0[3]); o.y = pk4_fp8(h1[0], h1[1], h1[2], h1[3]);
                *(u32x2*)rowp = o; }
    }
};

typedef int v8i __attribute__((ext_vector_type(8)));
typedef int v4i __attribute__((ext_vector_type(4)));
template <class Epi, class Sched, bool GATHER = false, bool FP8 = false>
__device__ __forceinline__ void gemm_phase(PG8_LAS unsigned char* lds, const Gemm g, const Sched& S, const Epi& E, const int tid) {
    const int wid = __builtin_amdgcn_readfirstlane(tid >> 6), lane = tid & 63, wr = wid >> 2, wc = wid & 3, fr = lane & 15, fq = lane >> 4;
    int K_ = g.K; asm volatile("" : "+s"(K_));
    const int K = K_, nt = K / BK;
    int sR[2], sC[2]; unsigned voffB[2][2];
#pragma unroll
    for (int i = 0; i < 2; ++i) { int R, C; stage_rc(tid * 16 + i * 8192, R, C); sR[i] = R; sC[i] = C;
#pragma unroll
        for (int h = 0; h < 2; ++h) { int Rb;
            if (Epi::PERM64) Rb = 64 * (R >> 5) + 16 * ((R & 15) >> 2) + 8 * h + 4 * ((R >> 4) & 1) + (R & 3);
            else Rb = (Epi::PERM ? ((R & ~31) + perm32(R & 31)) : R);
            voffB[h][i] = (unsigned)(Rb * K + C) * 2u; } }
    const size_t kstep = (size_t)(BK * 2);
    const size_t hstep = (size_t)HALF * K * 2;
    const size_t tstep = 2 * hstep;
    const unsigned ldsw = (unsigned)wid * 1024u;
    const int aoff = FP8 ? lds_byte(wr * 64 + fr, fq * 16) : lds_byte(wr * 64 + fr, fq * 8), boff = FP8 ? lds_byte(wc * 32 + fr, fq * 16) : lds_byte(wc * 32 + fr, fq * 8);
#define PG8_SA(b, h) (((b) * 2 + (h)) * HTB)
#define PG8_SB(b, h) ((4 + (b) * 2 + (h)) * HTB)
#define PG8_STAGE(bufoff, gbase, voff) do { _Pragma("unroll") for (int _i = 0; _i < 2; ++_i) \
        __builtin_amdgcn_global_load_lds((const unsigned*)((const char*)(gbase) + (voff)[_i]), (PG8_LAS unsigned*)(lds + (bufoff) + ldsw + _i * 8192), 16, 0, 0); } while (0)
#define PG8_LDA(dst, b, h) do { if constexpr (FP8) { _Pragma("unroll") for (int m = 0; m < 4; ++m) { dst##8[m].lo = *(const PG8_LAS v4i*)(lds + PG8_SA(b, h) + aoff + m * 2048); dst##8[m].hi = *(const PG8_LAS v4i*)(lds + PG8_SA(b, h) + aoff + m * 2048 + 16); } } \
        else { _Pragma("unroll") for (int m = 0; m < 4; ++m) _Pragma("unroll") for (int k = 0; k < 2; ++k) dst[m][k] = *(const PG8_LAS bf16x8*)(lds + PG8_SA(b, h) + aoff + m * 2048 + k * 1024); } } while (0)
#define PG8_LDB(dst, b, h) do { if constexpr (FP8) { _Pragma("unroll") for (int n = 0; n < 2; ++n) { dst##8[n].lo = *(const PG8_LAS v4i*)(lds + PG8_SB(b, h) + boff + n * 2048); dst##8[n].hi = *(const PG8_LAS v4i*)(lds + PG8_SB(b, h) + boff + n * 2048 + 16); } } \
        else { _Pragma("unroll") for (int n = 0; n < 2; ++n) _Pragma("unroll") for (int k = 0; k < 2; ++k) dst[n][k] = *(const PG8_LAS bf16x8*)(lds + PG8_SB(b, h) + boff + n * 2048 + k * 1024); } } while (0)
#define PG8_MMA(ai, bj, At, Bt) do { __builtin_amdgcn_s_setprio(1); _Pragma("unroll") for (int m = 0; m < 4; ++m) _Pragma("unroll") for (int n = 0; n < 2; ++n) { \
        if constexpr (FP8) asm volatile("v_mfma_scale_f32_16x16x128_f8f6f4 %0, %1, %2, %0, %3, %3 op_sel_hi:[0,0,0]" : "+v"(acc[ai][bj][m][n]) : "v"(Bt##8[n]), "v"(At##8[m]), "v"(unit_scale));   \
        else { _Pragma("unroll") for (int k = 0; k < 2; ++k) acc[ai][bj][m][n] = __builtin_amdgcn_mfma_f32_16x16x32_bf16(Bt[n][k], At[m][k], acc[ai][bj][m][n], 0, 0, 0); } } \
        __builtin_amdgcn_s_setprio(0); } while (0)
#define PG8_WAIT_V(n) asm volatile("s_waitcnt vmcnt(" #n ")" ::: "memory")
#define PG8_WAIT_L(n) asm volatile("s_waitcnt lgkmcnt(" #n ")" ::: "memory")
#define PG8_BAR __builtin_amdgcn_s_barrier()
#define PG8_SCHED __builtin_amdgcn_sched_barrier(0)
#define PG8_AOFF(dst, U, UI) do { _Pragma("unroll") for (int _h = 0; _h < 2; ++_h) _Pragma("unroll") for (int _i = 0; _i < 2; ++_i) { int _row = (U).pm * BM + _h * HALF + sR[_i]; \
        if (GATHER) _row = g.gather[(UI) * BM + _h * HALF + sR[_i]]; dst[_h][_i] = (unsigned)(_row * K + sC[_i]) * 2u; } } while (0)
    Unit cur, nxt; int ui = 0;
    if (!S.next(0, cur)) return;
    f32x4 acc[2][2][4][2];
#pragma unroll
    for (int a = 0; a < 2; ++a)
#pragma unroll
        for (int b = 0; b < 2; ++b)
#pragma unroll
            for (int m = 0; m < 4; ++m)
#pragma unroll
                for (int n = 0; n < 2; ++n) acc[a][b][m][n] = (f32x4){0.f, 0.f, 0.f, 0.f};
    const int unit_scale = 0x7f7f7f7f;
    bf16x8 At[4][2], B0[2][2], B1[2][2]; v8i At8[4], B08[2], B18[2];
    unsigned offA[2][2], offN[2][2];
    PG8_AOFF(offA, cur, 0);
#pragma unroll
    for (int h = 0; h < 2; ++h)
#pragma unroll
        for (int i = 0; i < 2; ++i) offN[h][i] = offA[h][i];
    const char* A0 = (const char*)g.A;
    const char* cB = (const char*)g.Bt + (size_t)cur.e * (size_t)g.bstride * 2 + (size_t)cur.pn * tstep;
    PG8_STAGE(PG8_SB(0, 0), cB, voffB[0]); PG8_STAGE(PG8_SB(0, 1), (cB) + (Epi::PERM64 ? 0 : hstep), voffB[Epi::PERM64 ? 1 : 0]); PG8_STAGE(PG8_SA(0, 0), A0, offA[0]); PG8_STAGE(PG8_SA(0, 1), A0, offA[1]);
    if (wr == 1) PG8_BAR;
    PG8_WAIT_V(2); PG8_BAR;
    PG8_STAGE(PG8_SB(1, 0), cB + kstep, voffB[0]); PG8_STAGE(PG8_SA(1, 0), A0 + kstep, offA[0]); PG8_STAGE(PG8_SB(1, 1), (cB + kstep) + (Epi::PERM64 ? 0 : hstep), voffB[Epi::PERM64 ? 1 : 0]);
    PG8_WAIT_V(6); PG8_BAR;
    for (;;) {
        const bool has_next = S.next(ui + 1, nxt);
        const char* nB = has_next ? (const char*)g.Bt + (size_t)nxt.e * (size_t)g.bstride * 2 + (size_t)nxt.pn * tstep : cB;
        for (int t = 0; t < nt; t += 2) {
            const bool last = (t == nt - 2);
            if (last && has_next) PG8_AOFF(offN, nxt, ui + 1);
            const char* a1 = A0 + (size_t)(t + 1) * kstep;
            const char* a2 = last ? A0 : A0 + (size_t)(t + 2) * kstep; const char* b2 = last ? nB : cB + (size_t)(t + 2) * kstep;
            const char* a3 = a2 + kstep; const char* b3 = b2 + kstep;
            unsigned o2[2][2];
#pragma unroll
            for (int h = 0; h < 2; ++h)
#pragma unroll
                for (int i = 0; i < 2; ++i) o2[h][i] = last ? offN[h][i] : offA[h][i];
            const bool relax = Epi::PERM64 && (t == 0) && (ui > 0);
#define PG8_WAIT_V8R() do { if (relax) { if constexpr (Epi::NSTORE == 8) PG8_WAIT_V(16); else if constexpr (Epi::NSTORE == 16) PG8_WAIT_V(24); else PG8_WAIT_V(8); } else PG8_WAIT_V(8); } while (0)
            PG8_LDB(B0, 0, 0); PG8_LDB(B1, 0, 1); PG8_SCHED; PG8_LDA(At, 0, 0); PG8_STAGE(PG8_SA(1, 1), a1, offA[1]);
            PG8_WAIT_V8R(); PG8_WAIT_L(0); PG8_BAR; PG8_MMA(0, 0, At, B0); PG8_MMA(0, 1, At, B1); PG8_BAR; PG8_SCHED;
            PG8_LDA(At, 0, 1); PG8_STAGE(PG8_SB(0, 0), b2, voffB[0]); PG8_STAGE(PG8_SB(0, 1), (b2) + (Epi::PERM64 ? 0 : hstep), voffB[Epi::PERM64 ? 1 : 0]); PG8_STAGE(PG8_SA(0, 0), a2, o2[0]);
            PG8_WAIT_V8R(); PG8_WAIT_L(0); PG8_BAR; PG8_MMA(1, 0, At, B0); PG8_MMA(1, 1, At, B1); PG8_BAR; PG8_SCHED;
#undef PG8_WAIT_V8R
            PG8_LDB(B0, 1, 0); PG8_LDB(B1, 1, 1); PG8_SCHED; PG8_LDA(At, 1, 0); PG8_STAGE(PG8_SA(0, 1), a2, o2[1]);
            PG8_WAIT_V(8); PG8_WAIT_L(0); PG8_BAR; PG8_MMA(0, 0, At, B0); PG8_MMA(0, 1, At, B1); PG8_BAR; PG8_SCHED;
            PG8_LDA(At, 1, 1); PG8_STAGE(PG8_SB(1, 0), b3, voffB[0]); PG8_STAGE(PG8_SB(1, 1), (b3) + (Epi::PERM64 ? 0 : hstep), voffB[Epi::PERM64 ? 1 : 0]); PG8_STAGE(PG8_SA(1, 0), a3, o2[0]);
            PG8_WAIT_V(8); PG8_WAIT_L(0); PG8_BAR; PG8_MMA(1, 0, At, B0); PG8_MMA(1, 1, At, B1); PG8_BAR; PG8_SCHED;
        }
        if (wr == 0) PG8_BAR;
        if constexpr (FP8) asm volatile("s_nop 15\n\ts_nop 15" ::: "memory");
        E(acc, cur, wr, wc, fr, fq);
        if (!has_next) break;
#pragma unroll
        for (int a = 0; a < 2; ++a)
#pragma unroll
            for (int b = 0; b < 2; ++b)
#pragma unroll
                for (int m = 0; m < 4; ++m)
#pragma unroll
                    for (int n = 0; n < 2; ++n) acc[a][b][m][n] = (f32x4){0.f, 0.f, 0.f, 0.f};
        cur = nxt; cB = nB; ++ui;
#pragma unroll
        for (int h = 0; h < 2; ++h)
#pragma unroll
            for (int i = 0; i < 2; ++i) offA[h][i] = offN[h][i];
        if (wr == 1) PG8_BAR;
    }
    PG8_WAIT_V(0);
    PG8_BAR;
#undef PG8_SA
#undef PG8_SB
#undef PG8_STAGE
#undef PG8_LDA
#undef PG8_LDB
#undef PG8_MMA
#undef PG8_WAIT_V
#undef PG8_WAIT_L
#undef PG8_BAR
#undef PG8_SCHED
#undef PG8_AOFF
}
}

namespace att {
using bf16 = unsigned short;
constexpr int D = 128, NW = 8, QBLK = 32, KVBLK = 64;
constexpr float SCALE = 0.088388347648318440f;
constexpr float THR = 8.f;
constexpr int LDQ = PROJ_W, LDK = KV_W, LDO = DM;
constexpr size_t SHM_V = KVBLK * D * 2, SHM_K = KVBLK * D * 2, SHM_ATTN = 2 * SHM_V + 2 * SHM_K + NW * 64 * 4;
using bf16x8 = __attribute__((ext_vector_type(8))) short;
using s16x4  = __attribute__((ext_vector_type(4))) short;
using f32x16 = __attribute__((ext_vector_type(16))) float;
using u32x4  = __attribute__((ext_vector_type(4))) unsigned;
#define KSWZ(row, colB) ((row) * 256 + ((colB) ^ (((row) & 7) << 4)))
#define SBAR() __builtin_amdgcn_sched_barrier(0)
__device__ __forceinline__ int crow(int r, int hi) { return (r & 3) + 8 * (r >> 2) + 4 * hi; }
__device__ __forceinline__ unsigned cvtpk(float lo, float hi) { unsigned r; asm volatile("v_cvt_pk_bf16_f32 %0, %1, %2" : "=v"(r) : "v"(lo), "v"(hi)); return r; }
__device__ __forceinline__ float bf2f(short s) { return __uint_as_float(((unsigned)(unsigned short)s) << 16); }

__device__ __forceinline__ void partialSM(f32x16& p0, f32x16& p1, float& m_reg, float& mn, float& alpha) {
  constexpr float C = SCALE * 1.4426950408889634f;
  float pmax = p0[0]; for (int r = 1; r < 16; ++r) pmax = fmaxf(pmax, p0[r]); for (int r = 0; r < 16; ++r) pmax = fmaxf(pmax, p1[r]);
  { auto rr = __builtin_amdgcn_permlane32_swap(__float_as_uint(pmax), __float_as_uint(pmax), false, false);
    pmax = fmaxf(__uint_as_float(rr[0]), __uint_as_float(rr[1])); }
  if (__builtin_expect(__all(pmax - m_reg <= THR / SCALE), 1)) { mn = m_reg; alpha = 1.f; }
  else { mn = fmaxf(m_reg, pmax); alpha = __builtin_amdgcn_exp2f((m_reg - mn) * C); m_reg = mn; }
  float mnC = -mn * C;
  for (int r = 0; r < 16; ++r) p0[r] = fmaf(p0[r], C, mnC); for (int r = 0; r < 16; ++r) p1[r] = fmaf(p1[r], C, mnC);
  for (int r = 0; r < 16; ++r) p0[r] = __builtin_amdgcn_exp2f(p0[r]);
}
__device__ __forceinline__ void finishSM(f32x16& p0, f32x16& p1, float alpha, float& l_reg, bf16x8& pa0, bf16x8& pa1, bf16x8& pa2, bf16x8& pa3) {
  for (int r = 0; r < 16; ++r) p1[r] = __builtin_amdgcn_exp2f(p1[r]);
  float ps = 0; for (int r = 0; r < 16; ++r) ps += p0[r]; for (int r = 0; r < 16; ++r) ps += p1[r];
  { auto rr = __builtin_amdgcn_permlane32_swap(__float_as_uint(ps), __float_as_uint(ps), false, false);
    ps = __uint_as_float(rr[0]) + __uint_as_float(rr[1]); }
  l_reg = l_reg * alpha + ps;
#define PK4(P, BASE, OUT) do { unsigned a0 = cvtpk(P[BASE + 0], P[BASE + 1]), a1 = cvtpk(P[BASE + 2], P[BASE + 3]);   \
    unsigned b0 = cvtpk(P[BASE + 4], P[BASE + 5]), b1 = cvtpk(P[BASE + 6], P[BASE + 7]);                              \
    auto r0 = __builtin_amdgcn_permlane32_swap(a0, b0, false, false); auto r1 = __builtin_amdgcn_permlane32_swap(a1, b1, false, false); \
    u32x4 w = {r0[0], r1[0], r0[1], r1[1]}; OUT = *reinterpret_cast<bf16x8*>(&w); } while (0)
  PK4(p0, 0, pa0); PK4(p0, 8, pa1); PK4(p1, 0, pa2); PK4(p1, 8, pa3);
#undef PK4
}
__device__ __forceinline__ void qkt(f32x16& p0, f32x16& p1, const bf16* Ks, const bf16x8* qr, int r32, int hi) {
  p0 = f32x16{}; p1 = f32x16{};
  for (int d0 = 0; d0 < 8; ++d0) { int cb = (d0 * 16 + hi * 8) * 2;
    bf16x8 b0 = *reinterpret_cast<const bf16x8*>((const char*)Ks + KSWZ(r32, cb));
    bf16x8 b1 = *reinterpret_cast<const bf16x8*>((const char*)Ks + KSWZ(32 + r32, cb));
    p0 = __builtin_amdgcn_mfma_f32_32x32x16_bf16(b0, qr[d0], p0, 0, 0, 0);
    p1 = __builtin_amdgcn_mfma_f32_32x32x16_bf16(b1, qr[d0], p1, 0, 0, 0); }
}
__device__ __forceinline__ int v_st(int k, int c) { const int kk = (k & ~0xC) | ((k & 4) << 1) | ((k & 8) >> 1); return ((kk >> 3) * 4 + (c >> 5)) * 512 + ((kk & 7) * 32 + (c & 31)) * 2; }
__device__ __forceinline__ int v_rd_base(int lane) { return ((lane & 3) << 3) | (((lane >> 2) & 3) << 6) | (((lane >> 4) & 1) << 5) | (((lane >> 5) & 1) << 8); }
constexpr int v_rd_off(int d0, int ks, int half) { return d0 * 512 + ks * 4096 + half * 2048; }
template <int OFF> __device__ __forceinline__ s16x4 tr_read(int vb) {
  s16x4 r; asm volatile("ds_read_b64_tr_b16 %0, %1 offset:%2" : "=&v"(r) : "v"(vb), "i"(OFF) : "memory"); return r;
}
template <int D0> __device__ __forceinline__ void pv_one(f32x16& od, int vb, bf16x8 pa0, bf16x8 pa1, bf16x8 pa2, bf16x8 pa3) {
  const s16x4 l0 = tr_read<v_rd_off(D0, 0, 0)>(vb), h0 = tr_read<v_rd_off(D0, 0, 1)>(vb), l1 = tr_read<v_rd_off(D0, 1, 0)>(vb), h1 = tr_read<v_rd_off(D0, 1, 1)>(vb);
  const s16x4 l2 = tr_read<v_rd_off(D0, 2, 0)>(vb), h2 = tr_read<v_rd_off(D0, 2, 1)>(vb), l3 = tr_read<v_rd_off(D0, 3, 0)>(vb), h3 = tr_read<v_rd_off(D0, 3, 1)>(vb);
  asm volatile("s_waitcnt lgkmcnt(0)" ::: "memory"); SBAR();
#define PK(L, H) (bf16x8){L[0], L[1], L[2], L[3], H[0], H[1], H[2], H[3]}
  od = __builtin_amdgcn_mfma_f32_32x32x16_bf16(pa0, PK(l0, h0), od, 0, 0, 0);
  od = __builtin_amdgcn_mfma_f32_32x32x16_bf16(pa1, PK(l1, h1), od, 0, 0, 0);
  od = __builtin_amdgcn_mfma_f32_32x32x16_bf16(pa2, PK(l2, h2), od, 0, 0, 0);
  od = __builtin_amdgcn_mfma_f32_32x32x16_bf16(pa3, PK(l3, h3), od, 0, 0, 0);
#undef PK
}
__device__ __forceinline__ void pv_d0(f32x16* o, int vb, bf16x8 pa0, bf16x8 pa1, bf16x8 pa2, bf16x8 pa3) {
  pv_one<0>(o[0], vb, pa0, pa1, pa2, pa3); pv_one<1>(o[1], vb, pa0, pa1, pa2, pa3); pv_one<2>(o[2], vb, pa0, pa1, pa2, pa3); pv_one<3>(o[3], vb, pa0, pa1, pa2, pa3);
}

__device__ __forceinline__ float rope_inv_freq(int f) { return __builtin_amdgcn_exp2f(-(float)f * (13.287712379549449f / 32.f)); }

__device__ __forceinline__ void attn_unit(const bf16* __restrict__ Qb, const bf16* __restrict__ Kh, const bf16* __restrict__ Vh, bf16* __restrict__ Ob, int seq, int t0,
                                          const float* __restrict__ qgain, char* lds) {
  const int tid = threadIdx.x, wid = tid >> 6, lane = tid & 63, r32 = lane & 31, hi = lane >> 5;
  bf16* V_lds = (bf16*)lds; bf16* K_lds = (bf16*)(lds + 2 * SHM_V);
  float* ws = (float*)(lds + 2 * SHM_V + 2 * SHM_K) + wid * 64; float* li_l = ws; float* al_l = ws + 32;
  float m_reg = -1e30f, l_reg = 0; f32x16 o[4] = {}; bf16x8 qr[8];
  {
    int hq = hi; asm volatile("" : "+v"(hq));
    const bf16* Qw = Qb + (long)(wid * QBLK + r32) * LDQ + hi * 8;
    bf16x8 qraw[8];
#pragma unroll
    for (int d0 = 0; d0 < 8; ++d0) qraw[d0] = *reinterpret_cast<const bf16x8*>(Qw + d0 * 16);
    float ss = 0.f;
#pragma unroll
    for (int d0 = 0; d0 < 8; ++d0)
#pragma unroll
      for (int j = 0; j < 8; ++j) { const float x = bf2f(qraw[d0][j]); ss += x * x; }
    ss += __shfl_xor(ss, 32);
    const float rinv = 1.0f / sqrtf(ss * (1.f / 128.f) + NORM_EPS);
    const int t = t0 + wid * QBLK + r32; const float prow = (float)(t / GRIDW), pcol = (float)(t % GRIDW);
#pragma unroll
    for (int blk = 0; blk < 2; ++blk) { const float pos = blk ? pcol : prow;
#pragma unroll
      for (int dd = 0; dd < 2; ++dd) { const int dlo = blk * 4 + dd, dhi = dlo + 2; unsigned wv[4];
        float ylo[8], yhi[8];
#pragma unroll
        for (int j = 0; j < 8; ++j) { const int f = dd * 16 + hq * 8 + j; const float ang = pos * rope_inv_freq(f); const float cs = __cosf(ang), sn = __sinf(ang);
          const float a = bf2f(qraw[dlo][j]) * rinv * qgain[dlo * 16 + hq * 8 + j], b = bf2f(qraw[dhi][j]) * rinv * qgain[dhi * 16 + hq * 8 + j];
          ylo[j] = a * cs - b * sn; yhi[j] = b * cs + a * sn; }
#pragma unroll
        for (int j = 0; j < 4; ++j) wv[j] = cvtpk(ylo[2 * j], ylo[2 * j + 1]);
        { u32x4 w = {wv[0], wv[1], wv[2], wv[3]}; qr[dlo] = *reinterpret_cast<bf16x8*>(&w); }
#pragma unroll
        for (int j = 0; j < 4; ++j) wv[j] = cvtpk(yhi[2 * j], yhi[2 * j + 1]);
        { u32x4 w = {wv[0], wv[1], wv[2], wv[3]}; qr[dhi] = *reinterpret_cast<bf16x8*>(&w); } } }
  }
  const int sr = tid >> 4, sc = (tid & 15) * 8, vst0 = v_st(sr, sc), vst1 = v_st(32 + sr, sc);
  const int vb0 = (int)(uintptr_t)V_lds + v_rd_base(lane);
  struct { bf16x8 vs0, vs1, ks0, ks1; } sr_[2];
#define SLOAD(i, k0) do { sr_[i].vs0 = *reinterpret_cast<const bf16x8*>(&Vh[(long)((k0) + sr) * LDK + sc]); sr_[i].vs1 = *reinterpret_cast<const bf16x8*>(&Vh[(long)((k0) + 32 + sr) * LDK + sc]); \
    sr_[i].ks0 = *reinterpret_cast<const bf16x8*>(&Kh[(long)((k0) + sr) * LDK + sc]); sr_[i].ks1 = *reinterpret_cast<const bf16x8*>(&Kh[(long)((k0) + 32 + sr) * LDK + sc]); } while (0)
#define SWRITE(b, i) do { *(bf16x8*)((char*)V_lds + (b) * SHM_V + vst0) = sr_[i].vs0;          \
    *(bf16x8*)((char*)V_lds + (b) * SHM_V + vst1) = sr_[i].vs1; int kc = sc * 2;               \
    *(bf16x8*)((char*)K_lds + (b) * SHM_K + KSWZ(sr, kc)) = sr_[i].ks0;                       \
    *(bf16x8*)((char*)K_lds + (b) * SHM_K + KSWZ(32 + sr, kc)) = sr_[i].ks1; } while (0)
#define SWAIT() asm volatile("s_waitcnt vmcnt(4)" ::: "memory")
#define RESC(a) do { if (__any((a) < 1.f)) { if (hi == 0) al_l[r32] = (a); asm volatile("s_waitcnt lgkmcnt(0)" ::: "memory"); \
    for (int d = 0; d < 4; ++d) for (int r = 0; r < 16; ++r) o[d][r] *= al_l[crow(r, hi)]; } } while (0)
  f32x16 pA0, pA1, pB0, pB1; float mnA, mnB, alA, alB; bf16x8 pa0, pa1, pa2, pa3; const int NT = seq / KVBLK;
  constexpr int SE = 0, SO = 1;
  SLOAD(SE, 0); asm volatile("s_waitcnt vmcnt(0)" ::: "memory"); SWRITE(0, SE); __syncthreads();
  qkt(pA0, pA1, K_lds, qr, r32, hi); partialSM(pA0, pA1, m_reg, mnA, alA);
  SLOAD(SO, KVBLK); if (2 < NT) SLOAD(SE, 2 * KVBLK);
  SWAIT(); SWRITE(1, SO); __syncthreads();
  for (int j = 1; j + 1 < NT; j += 2) {
    SBAR(); qkt(pB0, pB1, (bf16*)((char*)K_lds + SHM_K), qr, r32, hi);
    finishSM(pA0, pA1, alA, l_reg, pa0, pa1, pa2, pa3); SBAR();
    SLOAD(SO, (j + 2) * KVBLK); SBAR();
    pv_d0(o, vb0, pa0, pa1, pa2, pa3); partialSM(pB0, pB1, m_reg, mnB, alB);
    __syncthreads(); SWAIT(); SWRITE(0, SE);
    RESC(alB); __syncthreads();
    SBAR(); qkt(pA0, pA1, K_lds, qr, r32, hi);
    finishSM(pB0, pB1, alB, l_reg, pa0, pa1, pa2, pa3); SBAR();
    if (j + 3 < NT) SLOAD(SE, (j + 3) * KVBLK); SBAR();
    pv_d0(o, vb0 + (int)SHM_V, pa0, pa1, pa2, pa3); partialSM(pA0, pA1, m_reg, mnA, alA);
    __syncthreads(); SWAIT(); SWRITE(1, SO);
    RESC(alA); __syncthreads();
  }
  SBAR(); qkt(pB0, pB1, (bf16*)((char*)K_lds + SHM_K), qr, r32, hi);
  finishSM(pA0, pA1, alA, l_reg, pa0, pa1, pa2, pa3); SBAR();
  pv_d0(o, vb0, pa0, pa1, pa2, pa3); partialSM(pB0, pB1, m_reg, mnB, alB);
  __syncthreads(); RESC(alB);
  finishSM(pB0, pB1, alB, l_reg, pa0, pa1, pa2, pa3); SBAR();
  pv_d0(o, vb0 + (int)SHM_V, pa0, pa1, pa2, pa3);
  if (hi == 0) li_l[r32] = l_reg; asm volatile("s_waitcnt lgkmcnt(0)" ::: "memory");
  float rli[16];
#pragma unroll
  for (int r = 0; r < 16; ++r) rli[r] = __builtin_amdgcn_rcpf(li_l[crow(r, hi)]);
  bf16* Ow = Ob + (long)(wid * QBLK) * LDO;
#pragma unroll
  for (int r = 0; r < 16; ++r) { int orow = crow(r, hi);
    for (int d0 = 0; d0 < 4; ++d0) { const float v = o[d0][r] * rli[r]; unsigned u = __float_as_uint(v); u = (u + 0x7fffu + ((u >> 16) & 1u)) >> 16;
      Ow[(long)orow * LDO + d0 * 32 + r32] = (bf16)u; } }
  __syncthreads();
#undef SLOAD
#undef SWRITE
#undef SWAIT
#undef RESC
}
}

namespace att8 {
#define LAS3 __attribute__((address_space(3)))
using att::crow; using att::bf2f;
typedef int v8i __attribute__((ext_vector_type(8)));
typedef int v4i __attribute__((ext_vector_type(4)));
using f32x16 = __attribute__((ext_vector_type(16))) float;
using bf16x8 = __attribute__((ext_vector_type(8))) short;
using bf16 = unsigned short;
constexpr int D = 128, NW = 8, QBLK = 32, KVBLK = 64;
constexpr float K8_SCALE = 8.f, V8_SCALE = 8.f, P8_SHIFT = 5.f;
constexpr float Q8_SCALE = 0.088388347648318440f * 1.4426950408889634f * 512.f / K8_SCALE;
constexpr int Q8_BLOCK_SCALE = 0x76767676;
constexpr float THR2 = 2.f * 1.4426950408889634f;
constexpr int LDQ = PROJ_W, LDO = DM;
constexpr int RING = 8, SHM_T = KVBLK * D, SHM_ATTN = 2 * RING * SHM_T + NW * 64 * 4;
__device__ __forceinline__ unsigned pk4(float a, float b, float c, float d) { int w; asm("" : "=v"(w)); w = __builtin_amdgcn_cvt_pk_fp8_f32(a, b, w, false); w = __builtin_amdgcn_cvt_pk_fp8_f32(c, d, w, true); return (unsigned)w; }
__device__ __forceinline__ int k_off(int key, int c) { return key * 128 + ((c ^ ((key >> 1) & 7)) << 4); }
__device__ __forceinline__ int v_off(int d, int c) { return d * 64 + ((c ^ ((d >> 2) & 3)) << 4); }

typedef short v2s __attribute__((ext_vector_type(2)));
__device__ __forceinline__ unsigned pk4s(float a, float b, float c, float d, float sc) { v2s w; asm("" : "=v"(w) : "v"(a));
  w = __builtin_amdgcn_cvt_scalef32_pk_fp8_f32(w, a, b, sc, false); w = __builtin_amdgcn_cvt_scalef32_pk_fp8_f32(w, c, d, sc, true); return __builtin_bit_cast(unsigned, w); }
__device__ __forceinline__ float rowmax32(const f32x16& p0, const f32x16& p1) {
  float pmax = p0[0]; for (int r = 1; r < 16; ++r) pmax = fmaxf(pmax, p0[r]); for (int r = 0; r < 16; ++r) pmax = fmaxf(pmax, p1[r]);
  auto rr = __builtin_amdgcn_permlane32_swap(__float_as_uint(pmax), __float_as_uint(pmax), false, false);
  return fmaxf(__uint_as_float(rr[0]), __uint_as_float(rr[1]));
}
__device__ __forceinline__ void partialSM_first(f32x16& p0, f32x16& p1, float& m_reg, float& sc, float& lim, float& alpha) {
  const float pmax = rowmax32(p0, p1);
  m_reg = ceilf(pmax); alpha = 1.f; sc = __builtin_amdgcn_exp2f(m_reg - P8_SHIFT); lim = fminf(m_reg + THR2, 126.f);
  for (int r = 0; r < 16; ++r) { p0[r] = fminf(p0[r], 126.f); p1[r] = fminf(p1[r], 126.f); }
  for (int r = 0; r < 16; ++r) p0[r] = __builtin_amdgcn_exp2f(p0[r]);
}
__device__ __forceinline__ void partialSM(f32x16& p0, f32x16& p1, float& m_reg, float& sc, float& lim, float& alpha) {
  const float pmax = rowmax32(p0, p1);
  if (__builtin_expect(__all(pmax <= lim), 1)) { alpha = 1.f; }
  else { const float mn = fmaxf(m_reg, ceilf(pmax)); alpha = __builtin_amdgcn_exp2f(m_reg - mn); m_reg = mn; sc = __builtin_amdgcn_exp2f(m_reg - P8_SHIFT); lim = fminf(m_reg + THR2, 126.f);
    for (int r = 0; r < 16; ++r) { p0[r] = fminf(p0[r], 126.f); p1[r] = fminf(p1[r], 126.f); } }
  for (int r = 0; r < 16; ++r) p0[r] = __builtin_amdgcn_exp2f(p0[r]);
}
__device__ __forceinline__ void finishSM(f32x16& p0, f32x16& p1, float sc, v8i& pf) {
  for (int r = 0; r < 16; ++r) p1[r] = __builtin_amdgcn_exp2f(p1[r]);
#pragma unroll
  for (int i = 0; i < 4; ++i) { const unsigned a = pk4s(p0[4 * i], p0[4 * i + 1], p0[4 * i + 2], p0[4 * i + 3], sc), b = pk4s(p1[4 * i], p1[4 * i + 1], p1[4 * i + 2], p1[4 * i + 3], sc);
    auto r = __builtin_amdgcn_permlane32_swap(a, b, false, false); pf[2 * i] = (int)r[0]; pf[2 * i + 1] = (int)r[1]; }
}
__device__ __forceinline__ v8i ld32(const char* base, int o0, int o1) { v8i f; f.lo = *reinterpret_cast<const v4i*>(base + o0); f.hi = *reinterpret_cast<const v4i*>(base + o1); return f; }
__device__ __forceinline__ void qkt_ld(v8i (&kf)[4], const char* Ks, int r32, int hi) {
  kf[0] = ld32(Ks, k_off(r32, hi), k_off(r32, 2 + hi)); kf[1] = ld32(Ks, k_off(32 + r32, hi), k_off(32 + r32, 2 + hi));
  kf[2] = ld32(Ks, k_off(r32, 4 + hi), k_off(r32, 6 + hi)); kf[3] = ld32(Ks, k_off(32 + r32, 4 + hi), k_off(32 + r32, 6 + hi));
}
__device__ __forceinline__ void qkt_mma(f32x16& p0, f32x16& p1, const v8i (&kf)[4], const v8i (&qf)[2]) {
  const f32x16 z = {};
  p0 = __builtin_amdgcn_mfma_scale_f32_32x32x64_f8f6f4(kf[0], qf[0], z, 0, 0, 0, 0x7f7f7f7f, 0, Q8_BLOCK_SCALE);
  p1 = __builtin_amdgcn_mfma_scale_f32_32x32x64_f8f6f4(kf[1], qf[0], z, 0, 0, 0, 0x7f7f7f7f, 0, Q8_BLOCK_SCALE);
  p0 = __builtin_amdgcn_mfma_scale_f32_32x32x64_f8f6f4(kf[2], qf[1], p0, 0, 0, 0, 0x7f7f7f7f, 0, Q8_BLOCK_SCALE);
  p1 = __builtin_amdgcn_mfma_scale_f32_32x32x64_f8f6f4(kf[3], qf[1], p1, 0, 0, 0, 0x7f7f7f7f, 0, Q8_BLOCK_SCALE);
}
__device__ __forceinline__ void pv_ld(v8i (&vf)[4], const char* Vs, int r32, int hi) {
  vf[0] = ld32(Vs, v_off(r32, 2 * hi), v_off(r32, 2 * hi + 1)); vf[1] = ld32(Vs, v_off(32 + r32, 2 * hi), v_off(32 + r32, 2 * hi + 1));
  vf[2] = ld32(Vs, v_off(64 + r32, 2 * hi), v_off(64 + r32, 2 * hi + 1)); vf[3] = ld32(Vs, v_off(96 + r32, 2 * hi), v_off(96 + r32, 2 * hi + 1));
}
__device__ __forceinline__ void pv_mma(f32x16* o, f32x16& ol, v8i pf, const v8i (&vf)[4], const v4i& ones) {
  const int us = 0x7f7f7f7f;
  asm volatile("s_nop 4\n\t"
               "v_mfma_scale_f32_32x32x64_f8f6f4 %0, %5, %6, %0, %11, %11 op_sel_hi:[0,0,0]\n\t"
               "v_mfma_scale_f32_32x32x64_f8f6f4 %1, %5, %7, %1, %11, %11 op_sel_hi:[0,0,0]\n\t"
               "v_mfma_scale_f32_32x32x64_f8f6f4 %2, %5, %8, %2, %11, %11 op_sel_hi:[0,0,0]\n\t"
               "v_mfma_scale_f32_32x32x64_f8f6f4 %3, %5, %9, %3, %11, %11 op_sel_hi:[0,0,0]\n\t"
               "v_mfma_scale_f32_32x32x64_f8f6f4 %4, %5, %10, %4, %11, %11 op_sel_hi:[0,0,0] blgp:4"
               : "+v"(o[0]), "+v"(o[1]), "+v"(o[2]), "+v"(o[3]), "+v"(ol)
               : "v"(pf), "v"(vf[0]), "v"(vf[1]), "v"(vf[2]), "v"(vf[3]), "v"(ones), "v"(us));
}
__device__ __forceinline__ void attn_unit(const bf16* __restrict__ Qb, const unsigned char* __restrict__ K8, const unsigned char* __restrict__ VT8, int vt_ld, bf16* __restrict__ Ob, int seq, int t0,
                                          const float* __restrict__ qgain, char* lds, LAS3 unsigned char* ldsa, const int tid_in) {
  int tid_ = tid_in; asm volatile("" : "+v"(tid_));
  const int tid = tid_, wid = __builtin_amdgcn_readfirstlane(tid >> 6), lane = tid & 63, r32 = lane & 31, hi = lane >> 5;
  char* K_lds = lds; char* V_lds = lds + RING * SHM_T;
  float* ws = (float*)(lds + 2 * RING * SHM_T) + wid * 64; float* li_l = ws; float* al_l = ws + 32;
  float m_reg = -1e30f; f32x16 o[4] = {}, ol = {}; v8i qf[2];
  v4i ones; { int e1 = 0x22222222; asm volatile("" : "+v"(e1)); ones[0] = e1; asm volatile("" : "+v"(e1)); ones[1] = e1; asm volatile("" : "+v"(e1)); ones[2] = e1; asm volatile("" : "+v"(e1)); ones[3] = e1; }
  {
    int tq = tid; asm volatile("" : "+v"(tq));
    const int hq = (tq >> 5) & 1;
    const bf16* Qw = Qb + (long)((tq >> 6) * QBLK + (tq & 31)) * LDQ + hq * 16;
    bf16x8 qraw[2][2][2];
#pragma unroll
    for (int ks = 0; ks < 2; ++ks)
#pragma unroll
      for (int g = 0; g < 2; ++g) { qraw[ks][g][0] = *reinterpret_cast<const bf16x8*>(Qw + ks * 64 + g * 32); qraw[ks][g][1] = *reinterpret_cast<const bf16x8*>(Qw + ks * 64 + g * 32 + 8); }
    float ss = 0.f;
#pragma unroll
    for (int ks = 0; ks < 2; ++ks)
#pragma unroll
      for (int g = 0; g < 2; ++g)
#pragma unroll
        for (int j = 0; j < 16; ++j) { const float x = bf2f(qraw[ks][g][j >> 3][j & 7]); ss += x * x; }
    { auto rr = __builtin_amdgcn_permlane32_swap(__float_as_uint(ss), __float_as_uint(ss), false, false); ss = __uint_as_float(rr[0]) + __uint_as_float(rr[1]); }
    const float rinv = Q8_SCALE / sqrtf(ss * (1.f / 128.f) + NORM_EPS);
    const int t = t0 + wid * QBLK + r32; const float prow = (float)(t / GRIDW), pcol = (float)(t % GRIDW);
#pragma unroll
    for (int ks = 0; ks < 2; ++ks) { const float pos = ks ? pcol : prow; float ylo[16], yhi[16];
#pragma unroll
      for (int j = 0; j < 16; ++j) { const int f = hq * 16 + j; const float ang = pos * att::rope_inv_freq(f); const float cs = __cosf(ang), sn = __sinf(ang);
        const float a = bf2f(qraw[ks][0][j >> 3][j & 7]) * rinv * qgain[ks * 64 + f], b = bf2f(qraw[ks][1][j >> 3][j & 7]) * rinv * qgain[ks * 64 + 32 + f];
        ylo[j] = a * cs - b * sn; yhi[j] = b * cs + a * sn; }
#pragma unroll
      for (int i = 0; i < 4; ++i) { qf[ks][i] = (int)pk4(ylo[4 * i], ylo[4 * i + 1], ylo[4 * i + 2], ylo[4 * i + 3]); qf[ks][4 + i] = (int)pk4(yhi[4 * i], yhi[4 * i + 1], yhi[4 * i + 2], yhi[4 * i + 3]); } }
  }
  const int skey = tid >> 3, sck = tid & 7, sd = tid >> 2, scv = tid & 3;
  const unsigned kgo = (unsigned)(skey * KV_W + ((sck ^ ((skey >> 1) & 7)) << 4)), vgo = (unsigned)(sd * vt_ld + ((scv ^ ((sd >> 2) & 3)) << 4));
  const int NT = seq / KVBLK;
  LAS3 unsigned char* Kd = ldsa + wid * 1024; LAS3 unsigned char* Vd = ldsa + RING * SHM_T + wid * 1024;
#define KDMA(t) do { const int t_ = (t) < NT ? (t) : NT - 1; __builtin_amdgcn_global_load_lds((const unsigned*)(K8 + (kgo + (unsigned)(t_ * KVBLK) * KV_W)), (LAS3 unsigned*)(Kd + ((t) & 7) * SHM_T), 16, 0, 0); } while (0)
#define VDMA(t) do { const int t_ = (t) < NT ? (t) : NT - 1; __builtin_amdgcn_global_load_lds((const unsigned*)(VT8 + (vgo + (unsigned)(t_ * KVBLK))), (LAS3 unsigned*)(Vd + ((t) & 7) * SHM_T), 16, 0, 0); } while (0)
#define RESC(a) do { if (__any((a) < 1.f)) { if (hi == 0) al_l[r32] = (a); asm volatile("s_waitcnt lgkmcnt(0)" ::: "memory"); \
    for (int r = 0; r < 16; ++r) { const float a_ = al_l[crow(r, hi)]; ol[r] *= a_; for (int d = 0; d < 4; ++d) o[d][r] *= a_; } } } while (0)
  f32x16 pA0, pA1, pB0, pB1; float alA, alB, sc, lim; v8i pf;
  v8i kf[4], vf[4];
#define WG_BAR(n) do { asm volatile("s_waitcnt vmcnt(" #n ")" ::: "memory"); __builtin_amdgcn_s_barrier(); asm volatile("" ::: "memory"); } while (0)
  KDMA(0); KDMA(1); KDMA(2); VDMA(0); VDMA(1); KDMA(3); KDMA(4); VDMA(2); VDMA(3); KDMA(5); KDMA(6); VDMA(4); VDMA(5);
  WG_BAR(8);
  qkt_ld(kf, K_lds, r32, hi); qkt_mma(pA0, pA1, kf, qf);
  qkt_ld(kf, K_lds + SHM_T, r32, hi); __builtin_amdgcn_sched_barrier(0);
  partialSM_first(pA0, pA1, m_reg, sc, lim, alA);
  WG_BAR(4);
  KDMA(7); KDMA(8); VDMA(6); VDMA(7);
  for (int j = 1; j + 1 < NT; j += 2) {
    qkt_mma(pB0, pB1, kf, qf);
    pv_ld(vf, V_lds + ((j - 1) & 7) * SHM_T, r32, hi); __builtin_amdgcn_sched_barrier(0);
    finishSM(pA0, pA1, sc, pf);
    pv_mma(o, ol, pf, vf, ones);
    qkt_ld(kf, K_lds + ((j + 1) & 7) * SHM_T, r32, hi); __builtin_amdgcn_sched_barrier(0);
    partialSM(pB0, pB1, m_reg, sc, lim, alB);
    RESC(alB);
    qkt_mma(pA0, pA1, kf, qf);
    pv_ld(vf, V_lds + (j & 7) * SHM_T, r32, hi); __builtin_amdgcn_sched_barrier(0);
    finishSM(pB0, pB1, sc, pf);
    pv_mma(o, ol, pf, vf, ones);
    qkt_ld(kf, K_lds + ((j + 2) & 7) * SHM_T, r32, hi); __builtin_amdgcn_sched_barrier(0);
    partialSM(pA0, pA1, m_reg, sc, lim, alA);
    RESC(alA);
    WG_BAR(4);
    KDMA(j + 8); KDMA(j + 9); VDMA(j + 7); VDMA(j + 8);
  }
  qkt_mma(pB0, pB1, kf, qf);
  pv_ld(vf, V_lds + ((NT - 2) & 7) * SHM_T, r32, hi); __builtin_amdgcn_sched_barrier(0);
  finishSM(pA0, pA1, sc, pf);
  pv_mma(o, ol, pf, vf, ones);
  pv_ld(vf, V_lds + ((NT - 1) & 7) * SHM_T, r32, hi); __builtin_amdgcn_sched_barrier(0);
  partialSM(pB0, pB1, m_reg, sc, lim, alB);
  RESC(alB);
  finishSM(pB0, pB1, sc, pf);
  pv_mma(o, ol, pf, vf, ones);
  asm volatile("s_nop 15\n\ts_nop 15" : "+v"(o[0]), "+v"(o[1]), "+v"(o[2]), "+v"(o[3]), "+v"(ol) :: "memory");
  float rli[16];
#pragma unroll
  for (int r = 0; r < 16; ++r) rli[r] = __builtin_amdgcn_rcpf(ol[r] * V8_SCALE);
  int te = tid; asm volatile("" : "+v"(te));
  const int r32e = te & 31, hie = (te >> 5) & 1, wide = te >> 6;
  bf16* Ow = Ob + (long)(wide * QBLK) * LDO;
#pragma unroll
  for (int r = 0; r < 16; ++r) { int orow = crow(r, hie);
    for (int d0 = 0; d0 < 4; ++d0) { const float v = o[d0][r] * rli[r]; unsigned u = __float_as_uint(v); u = (u + 0x7fffu + ((u >> 16) & 1u)) >> 16;
      Ow[(long)orow * LDO + d0 * 32 + r32e] = (bf16)u; } }
  asm volatile("s_waitcnt vmcnt(0)" ::: "memory");
  __syncthreads();
#undef KDMA
#undef VDMA
#undef WG_BAR
#undef RESC
}
}

constexpr int NWAVES = 8, NTHREADS = NWAVES * 64;
constexpr int N_PHASES = 14;
constexpr int N_LAUNCHES = MK_N_LAUNCHES;
static_assert(N_LAUNCHES == 1 || N_LAUNCHES == N_PHASES, "MK_N_LAUNCHES is 1 or 14");

constexpr size_t MiB = 1u << 20;
constexpr size_t WS_CTL = 0, CTL_ZERO_BYTES = 1 * MiB;
constexpr size_t WS_MODL = 1 * MiB;
constexpr size_t WS_MODC = WS_MODL + 12288 * 4;
constexpr size_t WS_RBIAS = WS_MODC + 4096 * 4;
constexpr size_t WS_TILE_E = WS_RBIAS + 256;
constexpr size_t WS_TILE_ROW = WS_TILE_E + 4096;
constexpr size_t WS_WRHI = 2 * MiB;
constexpr size_t WS_WRLO = WS_WRHI + 64 * 2048 * 2;
constexpr size_t WS_GT = 3 * MiB;
constexpr size_t WS_TOPI = 4 * MiB;
constexpr size_t WS_TOPW = WS_TOPI + (size_t)SEQ * 8 * 4;
constexpr size_t WS_RANK = WS_TOPW + (size_t)SEQ * 8 * 4;
constexpr size_t WS_SLOT_TOK = 6 * MiB;
constexpr size_t WS_SLOT_OF = WS_SLOT_TOK + (size_t)MAX_SLOTS * 4;
constexpr size_t WS_SLOT_W = WS_SLOT_OF + (size_t)MAX_SLOTS * 4;
constexpr size_t WS_AGGP = 8 * MiB;
constexpr size_t AGG_BYTES = (size_t)2 * NCH * 1024 * 4;
constexpr size_t WS_AGGH = WS_AGGP + AGG_BYTES;
constexpr size_t WS_CIN = WS_AGGH + AGG_BYTES;
static_assert(WS_SLOT_W + (size_t)MAX_SLOTS * 4 <= WS_AGGP && WS_CIN + AGG_BYTES <= 25 * MiB && WS_RANK + (size_t)SEQ * 32 <= WS_SLOT_TOK, "ws misc map");
constexpr size_t WS_W2T = 25 * MiB;
constexpr size_t WS_HH = WS_W2T + (size_t)NEXP1 * 2048 * 512 * 2;
constexpr size_t WS_ARENA = WS_HH + (size_t)MAX_SLOTS * EFF * 2;
constexpr size_t WS_W13T = WS_ARENA;
constexpr size_t WS_V = WS_W13T + (size_t)NEXP1 * 1024 * 2048 * 2;
constexpr size_t WS_U = WS_V + 65 * MiB;
constexpr size_t WS_P = WS_U + (size_t)MTOT * DM * 2;
constexpr size_t WS_CAT = WS_P + 114 * MiB;
constexpr size_t WS_WINT = WS_CAT + (size_t)SEQ * DM * 2;
constexpr size_t WS_WOUTT = WS_WINT + (size_t)PROJ_W * DM * 2;
constexpr size_t WS_KN = WS_WOUTT + (size_t)DM * DM * 2;
constexpr size_t WS_VN = WS_KN + (size_t)MTOT * KV_W * 2;
constexpr size_t WS_END = WS_ARENA + (size_t)MAX_SLOTS * DM * 2;
constexpr size_t WS_Y = WS_ARENA;
constexpr size_t WS_MIX = WS_U;
static_assert(WS_VN + (size_t)MTOT * KV_W * 2 <= WS_END && (size_t)MTOT * PROJ_W * 2 <= 114 * MiB && (size_t)(SEQ + 1) * DM * 2 <= 65 * MiB, "ws arena map");
constexpr int CW_TMO = 0, CW_CODE = 1, CW_CNT = 64, CW_NT = 192, CW_BAR = 4096;

constexpr int RING_BYTES = 131072, PHASE_LDS = 143360, LDSCTL_OFF = PHASE_LDS, MISC_OFF = LDSCTL_OFF + 320, LDS_BYTES = 147456;

#define GAS __attribute__((address_space(1)))
#define LAS __attribute__((address_space(3)))
typedef unsigned short bf16;
typedef unsigned v4u __attribute__((ext_vector_type(4)));
typedef unsigned v2u __attribute__((ext_vector_type(2)));
typedef float f32x4 __attribute__((ext_vector_type(4)));
typedef short bf16x8 __attribute__((ext_vector_type(8)));
typedef float f32x16 __attribute__((ext_vector_type(16)));
typedef GAS unsigned gu32;
#define RLX_AGENT __ATOMIC_RELAXED, __HIP_MEMORY_SCOPE_AGENT
#define LDS_WAIT() asm volatile("s_waitcnt lgkmcnt(0)" ::: "memory")
#define VM_WAIT() asm volatile("s_waitcnt vmcnt(0)" ::: "memory")
__device__ __forceinline__ unsigned f2bf(float f) { unsigned u = __builtin_bit_cast(unsigned, f); return (u + 0x7fffu + ((u >> 16) & 1u)) >> 16; }
__device__ __forceinline__ unsigned pk2(float lo, float hi) { return f2bf(lo) | (f2bf(hi) << 16); }
__device__ __forceinline__ float bf_lo(unsigned w) { return __uint_as_float(w << 16); }
__device__ __forceinline__ float bf_hi(unsigned w) { return __uint_as_float(w & 0xffff0000u); }
__device__ __forceinline__ float wave_sum(float v) {
#pragma unroll
    for (int o = 1; o < 64; o <<= 1) v += __shfl_xor(v, o);
    return v;
}

#define XB_TMO      128
#define XB_XCNT(j)  (256  + 64 * (j))
#define XB_XSUB(j)  (1280 + 64 * (j))
#define XB_XGEN(j)  (2304 + 64 * (j))
#define XB_TOP      3328
#define XB_TOPGEN   3392
#define XCD_BAR_WORDS 3456
#define XB_SPIN_CAP (1u << 18)
__device__ __forceinline__ unsigned xb_ld(unsigned* p)              { return __hip_atomic_load(p, __ATOMIC_RELAXED, __HIP_MEMORY_SCOPE_AGENT); }
__device__ __forceinline__ unsigned xb_add(unsigned* p, unsigned v) { return __hip_atomic_fetch_add(p, v, __ATOMIC_RELAXED, __HIP_MEMORY_SCOPE_AGENT); }
__device__ __forceinline__ unsigned xb_xcc_id() { return (unsigned)__builtin_amdgcn_s_getreg((3 << 11) | 20) & 0xFu; }
#define XB_SPIN(cond, bar) do { unsigned _sp = 0; while (cond) { __builtin_amdgcn_s_sleep(1); \
    if ((++_sp & 255u) == 0u) { if (xb_ld(&(bar)[XB_TMO])) break; if (_sp > XB_SPIN_CAP) { atomicAdd(&(bar)[XB_TMO], 1u); break; } } } } while (0)
struct XcdBarrier { unsigned* bar; unsigned x; volatile LAS unsigned* st; int w0; };
__device__ __forceinline__ bool xb_is_thread0(int w0) { return w0 == 0 && __builtin_amdgcn_mbcnt_hi(~0u, __builtin_amdgcn_mbcnt_lo(~0u, 0u)) == 0u; }
__device__ __forceinline__ XcdBarrier xcd_barrier_post(unsigned* bar, volatile LAS unsigned* st, int w0) {
    XcdBarrier b; b.bar = bar; b.x = xb_xcc_id(); b.st = st; b.w0 = w0;
    if (xb_is_thread0(w0)) (void)xb_add(&bar[XB_XCNT(b.x)], 1u);
    return b;
}
__device__ __forceinline__ void xcd_barrier_complete(unsigned* bar, unsigned x, unsigned& nloc, unsigned& nx) {
    const unsigned G = gridDim.x * gridDim.y * gridDim.z;
    unsigned sum, cnt, mine, sp = 0u;
    for (;;) {
        sum = 0u; cnt = 0u; mine = 0u;
#pragma unroll
        for (unsigned j = 0; j < 16; ++j) { const unsigned c = xb_ld(&bar[XB_XCNT(j)]); sum += c; cnt += (c > 0u) ? 1u : 0u; mine = (j == x) ? c : mine; }
        if (sum == G) break;
        __builtin_amdgcn_s_sleep(1);
        if ((++sp & 255u) == 0u) { if (xb_ld(&bar[XB_TMO])) break; if (sp > XB_SPIN_CAP) { atomicAdd(&bar[XB_TMO], 1u); break; } }
    }
    nloc = mine > 0u ? mine : 1u; nx = cnt > 0u ? cnt : 1u;
}
__device__ __forceinline__ void xcd_barrier(const XcdBarrier& b) {
    asm volatile("s_waitcnt vmcnt(0)" ::: "memory");
    __syncthreads();
    if (xb_is_thread0(b.w0)) {
        unsigned* bar = b.bar;
        __builtin_amdgcn_s_waitcnt(0);
        unsigned nloc = b.st[0], nx = b.st[1];
        if (nloc == 0u) { xcd_barrier_complete(bar, b.x, nloc, nx); b.st[0] = nloc; b.st[1] = nx; }
        const unsigned old = xb_add(&bar[XB_XSUB(b.x)], 1u);
        const unsigned gen = old / nloc;
        if (old + 1u == (gen + 1u) * nloc) {
            __builtin_amdgcn_fence(__ATOMIC_RELEASE, "agent");
            asm volatile("s_waitcnt vmcnt(0)" ::: "memory");
            const unsigned og = xb_add(&bar[XB_TOP], 1u);
            const unsigned tg = og / nx;
            if (og + 1u == (tg + 1u) * nx) xb_add(&bar[XB_TOPGEN], 1u);
            else XB_SPIN(xb_ld(&bar[XB_TOPGEN]) == tg, bar);
            __builtin_amdgcn_fence(__ATOMIC_ACQUIRE, "agent");
            xb_add(&bar[XB_XGEN(b.x)], 1u);
            asm volatile("s_waitcnt vmcnt(0)" ::: "memory");
        } else {
            XB_SPIN(xb_ld(&bar[XB_XGEN(b.x)]) == gen, bar);
            __builtin_amdgcn_fence(__ATOMIC_ACQUIRE, "agent");
            asm volatile("s_waitcnt vmcnt(0)" ::: "memory");
        }
    }
    __syncthreads();
}

struct Frame {
    LAS unsigned char* lds; char* ldsg;
    volatile LAS unsigned* MISC;
    gu32* ctl;
    int tid, lane, wave, G, bid;
    const float* in[29]; float* out; unsigned char* ws;
};
__device__ __forceinline__ int ldi_agent(const void* p) { return __hip_atomic_load((const int*)p, __ATOMIC_RELAXED, __HIP_MEMORY_SCOPE_AGENT); }

__device__ __forceinline__ void tr_item(const float* W, int ldw, int k0, int n0, bf16* dst, int ldt, LAS float* scr, int lane) {
    const int kr = lane >> 4, nc = (lane & 15) * 4;
    f32x4 v[16];
#pragma unroll
    for (int i = 0; i < 16; ++i) v[i] = __builtin_nontemporal_load((const f32x4*)(W + (size_t)(k0 + 4 * i + kr) * ldw + n0 + nc));
#pragma unroll
    for (int i = 0; i < 16; ++i) { LAS float* p = scr + (4 * i + kr) * 65 + nc; p[0] = v[i].x; p[1] = v[i].y; p[2] = v[i].z; p[3] = v[i].w; }
    LDS_WAIT(); asm volatile("" ::: "memory");
    const int c = lane & 7;
#pragma unroll
    for (int j = 0; j < 8; ++j) { const int n = (lane >> 3) + 8 * j; const LAS float* s = scr + (8 * c) * 65 + n;
        v4u o; o.x = pk2(s[0 * 65], s[1 * 65]); o.y = pk2(s[2 * 65], s[3 * 65]); o.z = pk2(s[4 * 65], s[5 * 65]); o.w = pk2(s[6 * 65], s[7 * 65]);
        *(GAS v4u*)(dst + (size_t)n * ldt + k0 + 8 * c) = o; }
    LDS_WAIT(); asm volatile("" ::: "memory");
}
__device__ __forceinline__ void tr_item8(const float* W, int ldw, int k0, int n0, unsigned char* dst, int ldt, float wscale, LAS float* scr, int lane) {
    const int kr = lane >> 4, nc = (lane & 15) * 4;
    f32x4 v[16];
#pragma unroll
    for (int i = 0; i < 16; ++i) v[i] = __builtin_nontemporal_load((const f32x4*)(W + (size_t)(k0 + 4 * i + kr) * ldw + n0 + nc));
#pragma unroll
    for (int i = 0; i < 16; ++i) { LAS float* p = scr + (4 * i + kr) * 65 + nc; p[0] = v[i].x; p[1] = v[i].y; p[2] = v[i].z; p[3] = v[i].w; }
    LDS_WAIT(); asm volatile("" ::: "memory");
    const int c = lane & 3;
#pragma unroll
    for (int j = 0; j < 4; ++j) { const int n = (lane >> 2) + 16 * j; const LAS float* s = scr + (16 * c) * 65 + n;
        v4u o;
        o.x = pg8::pk4_fp8(s[0 * 65] * wscale, s[1 * 65] * wscale, s[2 * 65] * wscale, s[3 * 65] * wscale); o.y = pg8::pk4_fp8(s[4 * 65] * wscale, s[5 * 65] * wscale, s[6 * 65] * wscale, s[7 * 65] * wscale);
        o.z = pg8::pk4_fp8(s[8 * 65] * wscale, s[9 * 65] * wscale, s[10 * 65] * wscale, s[11 * 65] * wscale); o.w = pg8::pk4_fp8(s[12 * 65] * wscale, s[13 * 65] * wscale, s[14 * 65] * wscale, s[15 * 65] * wscale);
        *(GAS v4u*)(dst + (size_t)n * ldt + k0 + 16 * c) = o; }
    LDS_WAIT(); asm volatile("" ::: "memory");
}
__device__ __forceinline__ float silu_acc(float x) { return x / (1.f + expf(-x)); }
__device__ __forceinline__ void p0_prologue(Frame& F) {
    {
        LAS float* sL = (LAS float*)(F.lds);
        LAS float* sC = sL + 2048;
        LAS float* red = sC + 2048;
        const float* c = F.in[1]; const float* cc = F.in[3]; const float* wm = F.in[4]; const float* bm = F.in[5];
        float* modl = (float*)(F.ws + WS_MODL); float* modc = (float*)(F.ws + WS_MODC);
        bool filled = false;
        for (int item = F.bid; item < 192; item += F.G) {
            if (!filled) { for (int k = F.tid; k < 2048; k += NTHREADS) { sL[k] = silu_acc(c[k]); sC[k] = silu_acc(cc[k]); } filled = true; __syncthreads(); }
            const int cg = F.tid & 15, ks = F.tid >> 4, col = item * 64 + cg * 4; const bool doc = item < 64;
            f32x4 aL = {0.f, 0.f, 0.f, 0.f}, aC = {0.f, 0.f, 0.f, 0.f};
#pragma unroll 8
            for (int i = 0; i < 64; ++i) { const int k = ks + 32 * i; const f32x4 w = *(const f32x4*)(wm + (size_t)k * 12288 + col); aL += w * sL[k]; aC += w * sC[k]; }
            *(LAS f32x4*)(red + ks * 64 + cg * 4) = aL; *(LAS f32x4*)(red + 2048 + ks * 64 + cg * 4) = aC;
            __syncthreads();
            if (F.tid < 128) { const int which = F.tid >> 6, j = F.tid & 63; float s = 0.f;
#pragma unroll
                for (int q = 0; q < 32; ++q) s += red[which * 2048 + q * 64 + j];
                s += bm[item * 64 + j];
                if (which == 0) modl[item * 64 + j] = s; else if (doc) modc[item * 64 + j] = s; }
            __syncthreads();
        }
        __syncthreads();
    }
    LAS float* scr = (LAS float*)(F.lds + F.wave * 16640);
    const int gw = F.bid * NWAVES + F.wave, NGW = F.G * NWAVES;
    constexpr int I_IN = 32 * 56, I_OUT = 32 * 32, I_E13 = NEXP1 * 2 * 256, I_E2 = NEXP1 * 256, I_G = 32 * 4;
    constexpr int NITEMS = I_IN + I_OUT + I_E13 + I_E2 + I_G;
    for (int it = gw; it < NITEMS; it += NGW) {
        int r = it;
        if (r < I_IN) { const int kb = r / 56, nb = r % 56; tr_item(F.in[6], PROJ_W, 64 * kb, 64 * nb, (bf16*)(F.ws + WS_WINT) + (size_t)(64 * nb) * DM, DM, scr, F.lane); continue; } r -= I_IN;
        if (r < I_OUT) { const int kb = r / 32, nb = r % 32; tr_item(F.in[16], DM, 64 * kb, 64 * nb, (bf16*)(F.ws + WS_WOUTT) + (size_t)(64 * nb) * DM, DM, scr, F.lane); continue; } r -= I_OUT;
        if (r < I_E13) { const int e = r / 512, q = r % 512, mat = q / 256, kb = (q % 256) / 8, nb = q % 8, n0 = 64 * nb;
            const float* W = (e < NEXP) ? (mat ? F.in[22] : F.in[21]) + (size_t)e * DM * EFF : (mat ? F.in[25] : F.in[24]);
            unsigned char* dst = (unsigned char*)(F.ws + WS_W13T) + ((size_t)e * 1024 + (n0 >> 7) * 256 + mat * 128 + (n0 & 127)) * DM;
            tr_item8(W, EFF, 64 * kb, n0, dst, DM, W_SCALE, scr, F.lane); continue; } r -= I_E13;
        if (r < I_E2) { const int e = r / 256, q = r % 256, kb = q / 32, nb = q % 32;
            const float* W = (e < NEXP) ? F.in[23] + (size_t)e * EFF * DM : F.in[26];
            tr_item8(W, DM, 64 * kb, 64 * nb, (unsigned char*)(F.ws + WS_W2T) + ((size_t)e * DM + 64 * nb) * EFF, EFF, W_SCALE, scr, F.lane); continue; } r -= I_E2;
        { const int mi = r / 4, q = r % 4, kb = q / 2, nb = q % 2, d = mi >> 4, gate = (mi >> 3) & 1, h = mi & 7;
            const float* W = (gate ? F.in[13] : F.in[11]) + (size_t)(d * 8 + h) * 16384;
            tr_item(W, 128, 64 * kb, 64 * nb, (bf16*)(F.ws + WS_GT) + (size_t)mi * 16384 + (size_t)(64 * nb) * 128, 128, scr, F.lane); }
    }
}

__device__ __forceinline__ void p1_modulate(Frame& F) {
    const int gw = F.bid * NWAVES + F.wave, NGW = F.G * NWAVES;
    const float* modl = (const float*)(F.ws + WS_MODL); const float* modc = (const float*)(F.ws + WS_MODC);
    bf16* U = (bf16*)(F.ws + WS_U);
    for (int m = gw; m < MTOT; m += NGW) {
        const float* src = (m < CTXL) ? F.in[2] + (size_t)m * DM : F.in[0] + (size_t)(m - CTXL) * DM;
        const float* md = (m < CTXL) ? modc : modl;
        GAS unsigned long long* o8 = (GAS unsigned long long*)(U + (size_t)m * DM) + F.lane;
#pragma unroll
        for (int j = 0; j < 8; ++j) { const int col = 4 * F.lane + 256 * j; const f32x4 v = *(const f32x4*)(src + col), sh = *(const f32x4*)(md + col), sc = *(const f32x4*)(md + 2048 + col);
            const f32x4 u = v * (sc + 1.0f) + sh;
            o8[64 * j] = (unsigned long long)pk2(u.x, u.y) | ((unsigned long long)pk2(u.z, u.w) << 32); }
    }
    if (F.bid < NEXP) { const int e = F.bid; const float* wr = F.in[19]; bf16* hiP = (bf16*)(F.ws + WS_WRHI) + (size_t)e * DM; bf16* loP = (bf16*)(F.ws + WS_WRLO) + (size_t)e * DM; float bs = 0.f;
        float w0v[4], scv[4], shv[4];
#pragma unroll
        for (int i = 0; i < 4; ++i) { const int k = F.wave * 256 + F.lane + 64 * i; w0v[i] = wr[(size_t)k * NEXP + e]; scv[i] = modl[8192 + k]; shv[i] = modl[6144 + k]; }
#pragma unroll
        for (int i = 0; i < 4; ++i) { const int k = F.wave * 256 + F.lane + 64 * i; const float w = w0v[i] * (1.0f + scv[i]);
            const unsigned h = f2bf(w); const float hf = __uint_as_float(h << 16); hiP[k] = (bf16)h; loP[k] = (bf16)f2bf(w - hf); bs += shv[i] * w0v[i]; }
        bs = wave_sum(bs); float* red = (float*)F.ldsg;
        if (F.lane == 0) red[F.wave] = bs;
        __syncthreads();
        if (F.tid == 0) { float t = 0.f; for (int w = 0; w < NWAVES; ++w) t += red[w]; ((float*)(F.ws + WS_RBIAS))[e] = t; }
        __syncthreads(); }
    if (gw == NGW - 1) { GAS v4u* z = (GAS v4u*)((unsigned char*)(F.ws + WS_V) + (size_t)SEQ * DM);
        for (int i = F.lane; i < DM / 16; i += 64) z[i] = (v4u){0u, 0u, 0u, 0u}; }
}

__device__ __forceinline__ void p3_knorm(Frame& F) {
    const int gw = F.bid * NWAVES + F.wave, NGW = F.G * NWAVES;
    const bf16* P = (const bf16*)(F.ws + WS_P); bf16* KN = (bf16*)(F.ws + WS_KN); bf16* VN = (bf16*)(F.ws + WS_VN); const float* kg = F.in[8];
    const float g0 = kg[F.lane], g1 = kg[64 + F.lane]; const int f = F.lane & 31; const float ifr = att::rope_inv_freq(f);
    for (int it = gw; it < (MTOT / 4) * NKV; it += NGW) {
        const int m0 = (it >> 1) * 4, kvh = it & 1;
        float k0[4], k1[4]; unsigned short v0[4], v1[4];
#pragma unroll
        for (int i = 0; i < 4; ++i) { const bf16* p = P + (size_t)(m0 + i) * PROJ_W + COL_K + kvh * HD; const bf16* pv = P + (size_t)(m0 + i) * PROJ_W + COL_V + kvh * HD;
            k0[i] = __uint_as_float(((unsigned)p[F.lane]) << 16); k1[i] = __uint_as_float(((unsigned)p[64 + F.lane]) << 16); v0[i] = pv[F.lane]; v1[i] = pv[64 + F.lane]; }
#pragma unroll
        for (int i = 0; i < 4; ++i) { const int m = m0 + i;
            const float ss = wave_sum(k0[i] * k0[i] + k1[i] * k1[i]); const float rinv = 1.0f / sqrtf(ss * (1.f / 128.f) + NORM_EPS);
            float y0 = k0[i] * rinv * g0, y1 = k1[i] * rinv * g1;
            if (m >= CTXL) { const int t = m - CTXL; const float a0 = (float)(t / GRIDW) * ifr, a1 = (float)(t % GRIDW) * ifr;
                const float c0 = __cosf(a0), s0 = __sinf(a0), c1 = __cosf(a1), s1 = __sinf(a1);
                const float q0 = __shfl_xor(y0, 32), q1 = __shfl_xor(y1, 32);
                if (F.lane < 32) { y0 = y0 * c0 - q0 * s0; y1 = y1 * c1 - q1 * s1; } else { y0 = y0 * c0 + q0 * s0; y1 = y1 * c1 + q1 * s1; } }
            bf16* o = KN + (size_t)m * KV_W + kvh * HD; bf16* ov = VN + (size_t)m * KV_W + kvh * HD;
            o[F.lane] = (bf16)f2bf(y0); o[64 + F.lane] = (bf16)f2bf(y1); ov[F.lane] = v0[i]; ov[64 + F.lane] = v1[i]; }
    }
}

__device__ __forceinline__ void p3_knorm8(Frame& F) {
    const bf16* P = (const bf16*)(F.ws + WS_P); unsigned char* KN8 = (unsigned char*)(F.ws + WS_KN); unsigned char* VT8 = (unsigned char*)(F.ws + WS_VN); const float* kg = F.in[8];
    unsigned char* vt_l = (unsigned char*)F.ldsg;
    for (int it = F.bid; it < MTOT / 64; it += F.G) {
        const int m0 = it * 64;
        { const int row = F.tid >> 3, kvh = (F.tid >> 2) & 1, g = F.tid & 3, m = m0 + row;
          const bf16* kp = P + (size_t)m * PROJ_W + COL_K + kvh * HD + g * 8;
          v4u raw[2][2];
#pragma unroll
          for (int b = 0; b < 2; ++b) { raw[b][0] = *(const v4u*)(kp + b * 64); raw[b][1] = *(const v4u*)(kp + b * 64 + 32); }
          float x[2][2][8]; float ss = 0.f;
#pragma unroll
          for (int b = 0; b < 2; ++b)
#pragma unroll
            for (int q = 0; q < 2; ++q) { const v4u w = raw[b][q]; x[b][q][0] = bf_lo(w.x); x[b][q][1] = bf_hi(w.x); x[b][q][2] = bf_lo(w.y); x[b][q][3] = bf_hi(w.y); x[b][q][4] = bf_lo(w.z); x[b][q][5] = bf_hi(w.z); x[b][q][6] = bf_lo(w.w); x[b][q][7] = bf_hi(w.w);
#pragma unroll
              for (int i = 0; i < 8; ++i) ss += x[b][q][i] * x[b][q][i]; }
          ss += __shfl_xor(ss, 1); ss += __shfl_xor(ss, 2);
          const float rinv = att8::K8_SCALE / sqrtf(ss * (1.f / 128.f) + NORM_EPS);
          unsigned char* ko = KN8 + (size_t)m * KV_W + kvh * HD + g * 8;
#pragma unroll
          for (int b = 0; b < 2; ++b) { float lo[8], hi_[8]; const float pos = (m < CTXL) ? 0.f : (b ? (float)((m - CTXL) % GRIDW) : (float)((m - CTXL) / GRIDW));
#pragma unroll
            for (int i = 0; i < 8; ++i) { const int f = g * 8 + i; float cs = 1.f, sn = 0.f; if (m >= CTXL) { const float ang = pos * att::rope_inv_freq(f); cs = __cosf(ang); sn = __sinf(ang); }
                const float a = x[b][0][i] * rinv * kg[b * 64 + f], c = x[b][1][i] * rinv * kg[b * 64 + 32 + f]; lo[i] = a * cs - c * sn; hi_[i] = c * cs + a * sn; }
            *(v2u*)(ko + b * 64) = (v2u){att8::pk4(lo[0], lo[1], lo[2], lo[3]), att8::pk4(lo[4], lo[5], lo[6], lo[7])};
            *(v2u*)(ko + b * 64 + 32) = (v2u){att8::pk4(hi_[0], hi_[1], hi_[2], hi_[3]), att8::pk4(hi_[4], hi_[5], hi_[6], hi_[7])}; } }
        { const int row = F.tid >> 3, c = F.tid & 7, kvh = c >> 2, d0 = (c & 3) * 32; const bf16* vp = P + (size_t)(m0 + row) * PROJ_W + COL_V + kvh * HD + d0;
#pragma unroll
          for (int q = 0; q < 4; ++q) { const v4u w = *(const v4u*)(vp + q * 8); const float xv[8] = {bf_lo(w.x), bf_hi(w.x), bf_lo(w.y), bf_hi(w.y), bf_lo(w.z), bf_hi(w.z), bf_lo(w.w), bf_hi(w.w)};
#pragma unroll
            for (int i = 0; i < 8; i += 4) { const unsigned pk = att8::pk4(xv[i] * att8::V8_SCALE, xv[i + 1] * att8::V8_SCALE, xv[i + 2] * att8::V8_SCALE, xv[i + 3] * att8::V8_SCALE);
#pragma unroll
              for (int e = 0; e < 4; ++e) vt_l[(kvh * 128 + d0 + q * 8 + i + e) * 80 + row] = (unsigned char)(pk >> (8 * e)); } } }
        __syncthreads();
        {
          const int rowi = F.tid >> 1, half = F.tid & 1; const unsigned char* src = vt_l + rowi * 80 + half * 32;
          const v4u a = *(const v4u*)src, b = *(const v4u*)(src + 16);
          unsigned char* dst = VT8 + (size_t)rowi * MTOT + m0 + half * 32; *(v4u*)dst = a; *(v4u*)(dst + 16) = b; }
        __syncthreads();
    }
}

constexpr int RG_XCB = 0, RG_XCF = 16384, RG_XCH = 49152, RG_CWL = 81920;
__device__ __forceinline__ float log_sigmoid_f(float x) { return fminf(x, 0.f) - log1pf(expf(-fabsf(x))); }
__device__ __forceinline__ float gelu_tanh_f(float x) { const float u = 0.7978845608028654f * (x + 0.044715f * x * x * x); const float e = __expf(2.f * u); const float th = 1.f - 2.f * __builtin_amdgcn_rcpf(e + 1.f); return 0.5f * x * (1.f + th); }
__device__ __forceinline__ float sigmoid_fast(float x) { return __builtin_amdgcn_rcpf(1.f + __expf(-x)); }
__device__ __forceinline__ float one_minus_exp(float x) {
    const float ser = -x * (1.f + x * (0.5f + x * (0.16666667f + x * (0.041666668f + x * 0.0083333338f))));
    return (x > -0.25f) ? ser : (1.f - __expf(x));
}
template <int DIR, int PASS>
__device__ __forceinline__ void rg_scan(const float (&av)[16], float (&bv)[16], float carry, int hi, float& run_out, float& prod_out) {
    float gA[4], gB[4];
#pragma unroll
    for (int g = 0; g < 4; ++g) { float A_ = 1.f, B_ = 0.f;
#pragma unroll
        for (int jj = 0; jj < 4; ++jj) { const int r = 4 * g + (DIR ? 3 - jj : jj); B_ = av[r] * B_ + bv[r]; A_ *= av[r]; }
        gA[g] = A_; gB[g] = B_; }
    float pA[4], pB[4];
#pragma unroll
    for (int g = 0; g < 4; ++g) { pA[g] = __shfl_xor(gA[g], 32); pB[g] = __shfl_xor(gB[g], 32); }
    float cin[4] = {0.f, 0.f, 0.f, 0.f}; float run = carry, prod = 1.f;
#pragma unroll
    for (int s = 0; s < 8; ++s) { constexpr int dummy = 0; (void)dummy; const int G = DIR ? 7 - s : s, g = G >> 1, gh = G & 1;
        const bool mine = (gh == hi); const float A_ = mine ? gA[g] : pA[g], B_ = mine ? gB[g] : pB[g];
        cin[g] = mine ? run : cin[g];
        run = A_ * run + B_; prod *= A_; }
    if (PASS == 2) {
#pragma unroll
        for (int g = 0; g < 4; ++g) { float hs = cin[g];
#pragma unroll
            for (int jj = 0; jj < 4; ++jj) { const int r = 4 * g + (DIR ? 3 - jj : jj); hs = av[r] * hs + bv[r]; bv[r] = hs; } } }
    run_out = run; prod_out = prod;
}
template <int PASS>
__device__ __forceinline__ void rg_phase(Frame& F) {
    const bf16* P = (const bf16*)(F.ws + WS_P);
    char* L = F.ldsg;
    const int h = F.bid & 7, cs0 = F.bid >> 3, cstride = F.G >> 3;
    const int d = F.wave >> 2, q = F.wave & 3, r32 = F.lane & 31, hi = F.lane >> 5;
    constexpr int nch = (PASS == 1) ? NCH : NCH_LAT, cbase = (PASS == 1) ? 0 : NCH_CTX;
    bf16x8 BA[8], BX[8];
    { const bf16* GTa = (const bf16*)(F.ws + WS_GT) + (size_t)((d * 2 + 0) * 8 + h) * 16384 + (size_t)(q * 32 + r32) * 128 + hi * 8;
      const bf16* GTx = (const bf16*)(F.ws + WS_GT) + (size_t)((d * 2 + 1) * 8 + h) * 16384 + (size_t)(q * 32 + r32) * 128 + hi * 8;
#pragma unroll
      for (int ks = 0; ks < 8; ++ks) { BA[ks] = *(const bf16x8*)(GTa + ks * 16); BX[ks] = *(const bf16x8*)(GTx + ks * 16); } }
    const int ch = q * 32 + r32, gch = h * HD + ch;
    const float biasA = F.in[12][d * RG_W + gch], biasX = F.in[14][d * RG_W + gch], Lc = 8.0f * log_sigmoid_f(F.in[15][d * RG_W + gch]);
    const int tt = F.tid >> 4, cg = F.tid & 15, ch0 = h * HD + cg * 8;
    float* CWL = (float*)(L + RG_CWL);
    for (int i = F.tid; i < 5 * 128; i += NTHREADS) { const int j = i >> 7, c = i & 127; CWL[i] = (j < 4) ? F.in[9][j * RG_W + h * HD + c] : F.in[10][h * HD + c]; }
    __syncthreads();
    v4u raw[4];
#define RG_LOADRAW(CI) do { const int cidx_ = cbase + (CI); const bool ic_ = cidx_ < NCH_CTX; const int t_ = (ic_ ? cidx_ * RG_CH : (cidx_ - NCH_CTX) * RG_CH) + tt, sl_ = ic_ ? CTXL : SEQ, rb_ = ic_ ? 0 : CTXL; \
        _Pragma("unroll") for (int j = 0; j < 4; ++j) { const int ts = t_ + j - 2; raw[j] = (v4u){0u, 0u, 0u, 0u}; if (ts >= 0 && ts < sl_) raw[j] = *(const v4u*)(P + (size_t)(rb_ + ts) * PROJ_W + COL_XR + ch0); } } while (0)
    int ci = cs0; int buf = 0;
    if (ci < nch) RG_LOADRAW(ci);
    for (; ci < nch; ci += cstride, buf ^= 1) {
        const int cidx = cbase + ci; const bool isctx = cidx < NCH_CTX; const int t0 = isctx ? cidx * RG_CH : (cidx - NCH_CTX) * RG_CH;
        { float xc[8];
          { const f32x4 b0 = *(const f32x4*)(CWL + 4 * 128 + cg * 8), b1 = *(const f32x4*)(CWL + 4 * 128 + cg * 8 + 4);
            xc[0] = b0.x; xc[1] = b0.y; xc[2] = b0.z; xc[3] = b0.w; xc[4] = b1.x; xc[5] = b1.y; xc[6] = b1.z; xc[7] = b1.w; }
#pragma unroll
          for (int j = 0; j < 4; ++j) { const v4u rw = raw[j]; const f32x4 w0 = *(const f32x4*)(CWL + j * 128 + cg * 8), w1 = *(const f32x4*)(CWL + j * 128 + cg * 8 + 4);
            xc[0] += w0.x * bf_lo(rw.x); xc[1] += w0.y * bf_hi(rw.x); xc[2] += w0.z * bf_lo(rw.y); xc[3] += w0.w * bf_hi(rw.y);
            xc[4] += w1.x * bf_lo(rw.z); xc[5] += w1.y * bf_hi(rw.z); xc[6] += w1.z * bf_lo(rw.w); xc[7] += w1.w * bf_hi(rw.w); }
          float* xf = (float*)(L + RG_XCF + buf * 16384) + tt * 128 + cg * 8;
          *(f32x4*)xf = (f32x4){xc[0], xc[1], xc[2], xc[3]}; *(f32x4*)(xf + 4) = (f32x4){xc[4], xc[5], xc[6], xc[7]};
          v4u pb; pb.x = pk2(xc[0], xc[1]); pb.y = pk2(xc[2], xc[3]); pb.z = pk2(xc[4], xc[5]); pb.w = pk2(xc[6], xc[7]);
          *(v4u*)(L + RG_XCB + buf * 8192 + KSWZ(tt, cg * 16)) = pb; }
        if (ci + cstride < nch) RG_LOADRAW(ci + cstride);
        float carry = 0.f; unsigned short yq[8];
        if (PASS == 2) { carry = ((const float*)(F.ws + WS_CIN))[((size_t)d * NCH + cidx) * 1024 + gch];
            const bf16* yrp_ = P + (size_t)(CTXL + t0) * PROJ_W + COL_YR + gch;
#pragma unroll
            for (int r = 0; r < 8; ++r) yq[r] = yrp_[(size_t)(att::crow(r, hi) + (d ? 16 : 0)) * PROJ_W]; }
        __syncthreads();
        f32x16 accA = {}, accX = {};
#pragma unroll
        for (int ks = 0; ks < 8; ++ks) { const bf16x8 a = *(const bf16x8*)(L + RG_XCB + buf * 8192 + KSWZ(r32, (ks * 16 + hi * 8) * 2));
            accA = __builtin_amdgcn_mfma_f32_32x32x16_bf16(a, BA[ks], accA, 0, 0, 0); accX = __builtin_amdgcn_mfma_f32_32x32x16_bf16(a, BX[ks], accX, 0, 0, 0); }
        const float* xf = (const float*)(L + RG_XCF + buf * 16384);
        float av[16], bv[16];
#pragma unroll
        for (int r = 0; r < 16; ++r) { const int tok = att::crow(r, hi);
            const float rg = sigmoid_fast(accA[r] + biasA), ig = sigmoid_fast(accX[r] + biasX);
            const float la = rg * Lc; av[r] = __expf(la); bv[r] = __builtin_amdgcn_sqrtf(one_minus_exp(2.f * la)) * (ig * xf[tok * 128 + ch]); }
        float run, prod;
        if (d == 0) rg_scan<0, PASS>(av, bv, carry, hi, run, prod); else rg_scan<1, PASS>(av, bv, carry, hi, run, prod);
        if (PASS == 1) { if (hi == 0) { const size_t ai = ((size_t)d * NCH + cidx) * 1024 + gch; ((float*)(F.ws + WS_AGGP))[ai] = prod; ((float*)(F.ws + WS_AGGH))[ai] = run; } }
        else {
            float* xh = (float*)(L + RG_XCH + buf * 16384);
#pragma unroll
            for (int r = 0; r < 8; ++r) xh[(F.wave * 8 + r) * 64 + F.lane] = d ? bv[r] : bv[8 + r];
            __syncthreads();
            const float* ph = xh + ((F.wave ^ 4) * 8) * 64 + F.lane;
            bf16* cat = (bf16*)(F.ws + WS_CAT) + (size_t)t0 * DM + ATTN_W + gch;
#pragma unroll
            for (int r = 0; r < 8; ++r) { const int tok = att::crow(r, hi) + (d ? 16 : 0);
                const float y = __uint_as_float(((unsigned)yq[r]) << 16);
                const float o = ((d ? bv[8 + r] : bv[r]) + ph[r * 64]) * gelu_tanh_f(y);
                cat[(size_t)tok * DM] = (bf16)f2bf(o); }
        }
    }
    __syncthreads();
#undef RG_LOADRAW
}
__device__ __forceinline__ void p4_carry(Frame& F) {
    constexpr int PER = NCH / NWAVES; static_assert(PER * NWAVES == NCH && 2 * RG_W == 32 * 64, "carry-phase split");
    if (F.bid >= 32) return;
    const int d = F.bid >> 4, gch = (F.bid & 15) * 64 + F.lane;
    const float* AP = (const float*)(F.ws + WS_AGGP) + (size_t)d * NCH * 1024 + gch; const float* AH = (const float*)(F.ws + WS_AGGH) + (size_t)d * NCH * 1024 + gch;
    float* CI = (float*)(F.ws + WS_CIN) + (size_t)d * NCH * 1024 + gch;
    float* red = (float*)F.ldsg;
    float pv[PER], hv[PER];
#pragma unroll
    for (int j = 0; j < PER; ++j) { const int s = F.wave * PER + j; const int c = d == 0 ? s : (s < NCH_CTX ? NCH_CTX - 1 - s : NCH - 1 - (s - NCH_CTX)); pv[j] = AP[(size_t)c * 1024]; hv[j] = AH[(size_t)c * 1024]; }
    float A = 1.f, B = 0.f;
#pragma unroll
    for (int j = 0; j < PER; ++j) { B = pv[j] * B + hv[j]; A *= pv[j]; }
    red[(F.wave * 2) * 64 + F.lane] = A; red[(F.wave * 2 + 1) * 64 + F.lane] = B;
    __syncthreads();
    float carry = 0.f;
    for (int w = 0; w < F.wave; ++w) carry = red[(w * 2) * 64 + F.lane] * carry + red[(w * 2 + 1) * 64 + F.lane];
#pragma unroll
    for (int j = 0; j < PER; ++j) { const int s = F.wave * PER + j; const int c = d == 0 ? s : (s < NCH_CTX ? NCH_CTX - 1 - s : NCH - 1 - (s - NCH_CTX)); CI[(size_t)c * 1024] = carry; carry = pv[j] * carry + hv[j]; }
    __syncthreads();
}


__device__ __forceinline__ void p8_ln1(Frame& F) {
    const float* modl = (const float*)(F.ws + WS_MODL); const float* g = F.in[17]; const float* b = F.in[18];
    f32x4 xa[8], xb[8]; v2u ma[8], mb[8];
#define P8_LOAD(M0) do { const int m0_ = (M0), m1_ = m0_ + 1; \
        const f32x4* xi0 = (const f32x4*)(F.in[0] + (size_t)m0_ * DM) + F.lane; const f32x4* xi1 = (const f32x4*)(F.in[0] + (size_t)m1_ * DM) + F.lane; \
        const v2u* mx0 = (const v2u*)((const bf16*)(F.ws + WS_MIX) + (size_t)m0_ * DM) + F.lane; const v2u* mx1 = (const v2u*)((const bf16*)(F.ws + WS_MIX) + (size_t)m1_ * DM) + F.lane; \
        _Pragma("unroll") for (int j = 0; j < 8; ++j) { xa[j] = xi0[64 * j]; xb[j] = xi1[64 * j]; ma[j] = mx0[64 * j]; mb[j] = mx1[64 * j]; } } while (0)
    for (int it = F.bid; it < SEQ / 64; it += F.G) {
    const int rbase = it * 64 + F.wave * 8;
    P8_LOAD(rbase);
    for (int tr = 0; tr < 4; ++tr) { const int m0 = rbase + 2 * tr;
        const bool two = true; const int m1 = m0 + 1;
        GAS f32x4* xr0 = (GAS f32x4*)(F.out + (size_t)m0 * DM) + F.lane; GAS f32x4* xr1 = (GAS f32x4*)(F.out + (size_t)m1 * DM) + F.lane;
        int lo = F.lane; asm volatile("" : "+v"(lo));
        f32x4 v0[8], v1[8]; float s0 = 0.f, s1 = 0.f;
#pragma unroll
        for (int j = 0; j < 8; ++j) { const f32x4 g1v = *(const f32x4*)(modl + 4096 + 4 * lo + 256 * j);
            v0[j] = xa[j] * DN_ALPHA + g1v * (f32x4){bf_lo(ma[j].x), bf_hi(ma[j].x), bf_lo(ma[j].y), bf_hi(ma[j].y)};
            v1[j] = xb[j] * DN_ALPHA + g1v * (f32x4){bf_lo(mb[j].x), bf_hi(mb[j].x), bf_lo(mb[j].y), bf_hi(mb[j].y)}; }
        if (tr < 3) P8_LOAD(m0 + 2);
#pragma unroll
        for (int j = 0; j < 8; ++j) { s0 += (v0[j].x + v0[j].y) + (v0[j].z + v0[j].w); s1 += (v1[j].x + v1[j].y) + (v1[j].z + v1[j].w); }
        const float mean0 = wave_sum(s0) * (1.f / DM), mean1 = wave_sum(s1) * (1.f / DM); float q0 = 0.f, q1 = 0.f;
#pragma unroll
        for (int j = 0; j < 8; ++j) { v0[j] = v0[j] - mean0; v1[j] = v1[j] - mean1;
            q0 += (v0[j].x * v0[j].x + v0[j].y * v0[j].y) + (v0[j].z * v0[j].z + v0[j].w * v0[j].w); q1 += (v1[j].x * v1[j].x + v1[j].y * v1[j].y) + (v1[j].z * v1[j].z + v1[j].w * v1[j].w); }
        const float rstd0 = 1.0f / sqrtf(wave_sum(q0) * (1.f / DM) + NORM_EPS), rstd1 = 1.0f / sqrtf(wave_sum(q1) * (1.f / DM) + NORM_EPS);
        GAS unsigned* o80 = (GAS unsigned*)((unsigned char*)(F.ws + WS_V) + (size_t)m0 * DM) + F.lane;
        GAS unsigned* o81 = (GAS unsigned*)((unsigned char*)(F.ws + WS_V) + (size_t)m1 * DM) + F.lane;
#pragma unroll
        for (int j = 0; j < 8; ++j) { const int col = 4 * lo + 256 * j;
            const f32x4 gg = *(const f32x4*)(g + col), bb = *(const f32x4*)(b + col), sc = *(const f32x4*)(modl + 8192 + col) + 1.0f, sh = *(const f32x4*)(modl + 6144 + col);
            const f32x4 h0 = v0[j] * rstd0 * gg + bb; xr0[64 * j] = h0; const f32x4 u0 = (h0 * sc + sh) * V_SCALE;
            o80[64 * j] = pg8::pk4_fp8(u0.x, u0.y, u0.z, u0.w);
            if (two) { const f32x4 h1 = v1[j] * rstd1 * gg + bb; xr1[64 * j] = h1; const f32x4 u1 = (h1 * sc + sh) * V_SCALE;
                o81[64 * j] = pg8::pk4_fp8(u1.x, u1.y, u1.z, u1.w); } }
    }
    }
#undef P8_LOAD
}

__device__ __forceinline__ void p9_router(Frame& F) {
    const int r32 = F.lane & 31, hi = F.lane >> 5, rh = F.wave & 1, kq = F.wave >> 1;
    float* PART = (float*)F.ldsg;
    const bf16* WH = (const bf16*)(F.ws + WS_WRHI); const bf16* WL = (const bf16*)(F.ws + WS_WRLO);
    const float* rb = (const float*)(F.ws + WS_RBIAS); const float* eb = F.in[20];
    int* TOPI = (int*)(F.ws + WS_TOPI); float* TOPW = (float*)(F.ws + WS_TOPW); int* RANK = (int*)(F.ws + WS_RANK);
    for (int it = F.bid; it < SEQ / 64; it += F.G) {
        const int row0 = it * 64;
        { const float* hrow = F.out + (size_t)(row0 + rh * 32 + r32) * DM + kq * 512 + hi * 8;
          const bf16* wh0 = WH + (size_t)r32 * DM + kq * 512 + hi * 8; const bf16* wl0 = WL + (size_t)r32 * DM + kq * 512 + hi * 8;
          f32x16 acc0 = {}, acc1 = {};
#pragma unroll 4
          for (int ks = 0; ks < 32; ++ks) {
            const f32x4 a0 = *(const f32x4*)(hrow + ks * 16), a1 = *(const f32x4*)(hrow + ks * 16 + 4);
            v4u hw; hw.x = pk2(a0.x, a0.y); hw.y = pk2(a0.z, a0.w); hw.z = pk2(a1.x, a1.y); hw.w = pk2(a1.z, a1.w);
            v4u lw; lw.x = pk2(a0.x - bf_lo(hw.x), a0.y - bf_hi(hw.x)); lw.y = pk2(a0.z - bf_lo(hw.y), a0.w - bf_hi(hw.y));
            lw.z = pk2(a1.x - bf_lo(hw.z), a1.y - bf_hi(hw.z)); lw.w = pk2(a1.z - bf_lo(hw.w), a1.w - bf_hi(hw.w));
            const bf16x8 ah = *reinterpret_cast<bf16x8*>(&hw), al = *reinterpret_cast<bf16x8*>(&lw);
            const bf16x8 bh0 = *(const bf16x8*)(wh0 + ks * 16), bl0 = *(const bf16x8*)(wl0 + ks * 16);
            const bf16x8 bh1 = *(const bf16x8*)(wh0 + (size_t)32 * DM + ks * 16), bl1 = *(const bf16x8*)(wl0 + (size_t)32 * DM + ks * 16);
            acc0 = __builtin_amdgcn_mfma_f32_32x32x16_bf16(ah, bh0, acc0, 0, 0, 0); acc0 = __builtin_amdgcn_mfma_f32_32x32x16_bf16(al, bh0, acc0, 0, 0, 0); acc0 = __builtin_amdgcn_mfma_f32_32x32x16_bf16(ah, bl0, acc0, 0, 0, 0);
            acc1 = __builtin_amdgcn_mfma_f32_32x32x16_bf16(ah, bh1, acc1, 0, 0, 0); acc1 = __builtin_amdgcn_mfma_f32_32x32x16_bf16(al, bh1, acc1, 0, 0, 0); acc1 = __builtin_amdgcn_mfma_f32_32x32x16_bf16(ah, bl1, acc1, 0, 0, 0);
          }
          float* pp = PART + (size_t)kq * 64 * 65 + (size_t)(rh * 32) * 65;
#pragma unroll
          for (int r = 0; r < 16; ++r) { const int tok = att::crow(r, hi); pp[tok * 65 + r32] = acc0[r]; pp[tok * 65 + 32 + r32] = acc1[r]; } }
        __syncthreads();
        { const int row = F.wave * 8 + (F.lane >> 3), g = F.lane & 7;
          float bvv[8], scv[8];
#pragma unroll
          for (int j = 0; j < 8; ++j) { const int e = g * 8 + j; const float* p = PART + row * 65 + e;
            const float lg = ((p[0] + p[64 * 65]) + (p[2 * 64 * 65] + p[3 * 64 * 65])) + rb[e];
            scv[j] = 1.f / (1.f + expf(-lg)); bvv[j] = scv[j] + eb[e]; }
          float m1 = -INFINITY, m2 = -INFINITY;
#pragma unroll
          for (int j = 0; j < 8; ++j) { const float x = bvv[j]; if (x > m1) { m2 = m1; m1 = x; } else if (x > m2) m2 = x; }
          const float gs = m1 + m2; int rank = 0;
#pragma unroll
          for (int j = 0; j < 8; ++j) { const float o = __shfl(gs, j, 8); rank += (o > gs || (o == gs && j < g)) ? 1 : 0; }
          const bool gsel = rank < 4;
          if (!gsel) {
#pragma unroll
            for (int j = 0; j < 8; ++j) bvv[j] = -INFINITY; }
          int myidx = 0; float myw = 0.f;
#pragma unroll
          for (int k = 0; k < 8; ++k) { float bv_ = -INFINITY, bs_ = 0.f; int bi_ = 0;
#pragma unroll
            for (int j = 0; j < 8; ++j) if (bvv[j] > bv_) { bv_ = bvv[j]; bs_ = scv[j]; bi_ = g * 8 + j; }
            if (!gsel) bi_ = 64 + g;
#pragma unroll
            for (int o = 1; o < 8; o <<= 1) { const float ov = __shfl_xor(bv_, o, 8), os = __shfl_xor(bs_, o, 8); const int oi = __shfl_xor(bi_, o, 8);
                const bool take = (ov > bv_) || (ov == bv_ && oi < bi_); bv_ = take ? ov : bv_; bs_ = take ? os : bs_; bi_ = take ? oi : bi_; }
            if (g == k) { myidx = bi_; myw = bs_; }
#pragma unroll
            for (int j = 0; j < 8; ++j) if (bi_ == g * 8 + j) bvv[j] = -INFINITY; }
          float wsum = myw;
#pragma unroll
          for (int o = 1; o < 8; o <<= 1) wsum += __shfl_xor(wsum, o, 8);
          const int tokk = (row0 + row) * 8 + g;
          TOPI[tokk] = myidx; TOPW[tokk] = myw * (2.5f / wsum);
          RANK[tokk] = (int)__hip_atomic_fetch_add((unsigned*)(F.ctl + CW_CNT + myidx), 1u, RLX_AGENT); }
        __syncthreads();
    }
}

__device__ __forceinline__ void p10_dispatch(Frame& F) {
    int* cnt_s = (int*)F.ldsg; int* pst = cnt_s + 64;
    if (F.tid < NEXP) cnt_s[F.tid] = ldi_agent((const void*)(F.ctl + CW_CNT + F.tid));
    __syncthreads();
    if (F.tid == 0) { int run = 0; for (int e = 0; e < NEXP; ++e) { pst[e] = run; run += (cnt_s[e] + 255) & ~255; } pst[NEXP] = run; }
    __syncthreads();
    const int S_sh = pst[NEXP], ntr = S_sh >> 8;
    int* TILE_E = (int*)(F.ws + WS_TILE_E); int* TILE_ROW = (int*)(F.ws + WS_TILE_ROW);
    int* ST = (int*)(F.ws + WS_SLOT_TOK); int* SO = (int*)(F.ws + WS_SLOT_OF); float* SW = (float*)(F.ws + WS_SLOT_W);
    if (F.bid == 0) {
        if (F.tid < NEXP) { const int e = F.tid, n = (cnt_s[e] + 255) >> 8, t0 = pst[e] >> 8; for (int j = 0; j < n; ++j) { TILE_E[t0 + j] = e; TILE_ROW[t0 + j] = pst[e] + 256 * j; } }
        if (F.tid >= 64 && F.tid < 128) { const int j = F.tid - 64; TILE_E[ntr + j] = NEXP; TILE_ROW[ntr + j] = S_sh + 256 * j; }
        if (F.tid == 0) __hip_atomic_store((unsigned*)(F.ctl + CW_NT), (unsigned)(ntr + 64), RLX_AGENT);
    }
    const int gt = F.bid * NTHREADS + F.tid, NGT = F.G * NTHREADS;
    const int* TOPI = (const int*)(F.ws + WS_TOPI); const float* TOPW = (const float*)(F.ws + WS_TOPW); const int* RANK = (const int*)(F.ws + WS_RANK);
    for (int i = gt; i < SEQ * TOPK; i += NGT) { const int e = TOPI[i], slot = pst[e] + RANK[i]; ST[slot] = i >> 3; SO[(i >> 3) * 9 + (i & 7)] = slot; SW[slot] = TOPW[i]; }
    for (int i = gt; i < NEXP * 256; i += NGT) { const int e = i >> 8, j = i & 255, c = cnt_s[e], rem = c & 255;
        if (rem != 0 && j >= rem) { const int slot = pst[e] + (c & ~255) + j; ST[slot] = SEQ; SW[slot] = 0.f; } }
    for (int i = gt; i < SEQ; i += NGT) { const int slot = S_sh + i; ST[slot] = i; SO[i * 9 + 8] = slot; SW[slot] = 1.f; }
    __syncthreads();
}

constexpr int UT_OFF = RING_BYTES, GIDX_OFF = RING_BYTES + 512, MAX_UNITS_PER_WG = 32, MAX_GATHER_UNITS = 11;
static_assert(GIDX_OFF + MAX_GATHER_UNITS * 1024 <= PHASE_LDS, "LDS unit tables");
template <bool GATHER>
__device__ __forceinline__ int build_units(Frame& F, int ntile, int npn) {
    LAS int* ut = (LAS int*)(F.lds + UT_OFF); LAS int* gi = (LAS int*)(F.lds + GIDX_OFF);
    const int nwg = ntile * npn; int n = 0; if (F.bid < nwg) n = (nwg - 1 - F.bid) / F.G + 1;
    if (n > MAX_UNITS_PER_WG) n = MAX_UNITS_PER_WG; if (GATHER && n > MAX_GATHER_UNITS) n = MAX_GATHER_UNITS;
    const int* TILE_E = (const int*)(F.ws + WS_TILE_E); const int* TILE_ROW = (const int*)(F.ws + WS_TILE_ROW); const int* ST = (const int*)(F.ws + WS_SLOT_TOK);
    for (int i = F.tid; i < n; i += NTHREADS) { const int wgid = pg8::xcd_remap(i * F.G + F.bid, nwg), t = wgid / npn;
        ut[4 * i] = TILE_ROW[t] >> 8; ut[4 * i + 1] = wgid % npn; ut[4 * i + 2] = TILE_E[t]; ut[4 * i + 3] = 0; }
    __syncthreads();
    if (GATHER) { static_assert(MAX_GATHER_UNITS * 256 <= 6 * NTHREADS, "gather table fill is unrolled six deep");
        int gv[6];
#pragma unroll
        for (int k = 0; k < 6; ++k) { const int idx = F.tid + k * NTHREADS; gv[k] = (idx < n * 256) ? ST[ut[4 * (idx >> 8)] * 256 + (idx & 255)] : 0; }
#pragma unroll
        for (int k = 0; k < 6; ++k) { const int idx = F.tid + k * NTHREADS; if (idx < n * 256) gi[idx] = gv[k]; } }
    __syncthreads();
    return n;
}

__device__ __forceinline__ void p13_combine(Frame& F) {
    const int gw = F.bid * NWAVES + F.wave, NGW = F.G * NWAVES;
    const float* modl = (const float*)(F.ws + WS_MODL); const float* g = F.in[27]; const float* b = F.in[28];
    const unsigned char* Y = (const unsigned char*)(F.ws + WS_Y); const int* SO = (const int*)(F.ws + WS_SLOT_OF);
    v2u yv[9][4];
#define P13_LOAD(M, SLOT) do { _Pragma("unroll") for (int k = 0; k < 9; ++k) { const unsigned char* yr_ = Y + (size_t)__shfl((SLOT), k) * DM + 8 * F.lane; \
            _Pragma("unroll") for (int j = 0; j < 4; ++j) yv[k][j] = *(const v2u*)(yr_ + 512 * j); } } while (0)
    const int sel = F.lane < 9 ? F.lane : 8;
    int slot_n = 0, slot_nn = 0;
    f32x4 hq[8];
#define P13_LOADH(M) do { const float* hr_ = F.out + (size_t)(M) * DM + 8 * F.lane; _Pragma("unroll") for (int j = 0; j < 4; ++j) { hq[2 * j] = *(const f32x4*)(hr_ + 512 * j); hq[2 * j + 1] = *(const f32x4*)(hr_ + 512 * j + 4); } } while (0)
    if (gw < SEQ) { const int s0 = SO[gw * 9 + sel]; if (gw + NGW < SEQ) slot_n = SO[(gw + NGW) * 9 + sel]; P13_LOAD(gw, s0); }
    for (int m = gw; m < SEQ; m += NGW) {
        if (m + 2 * NGW < SEQ) slot_nn = SO[(m + 2 * NGW) * 9 + sel];
        P13_LOADH(m);
        float ff[4][8];
#pragma unroll
        for (int j = 0; j < 4; ++j)
#pragma unroll
            for (int i = 0; i < 8; ++i) ff[j][i] = 0.f;
#pragma unroll
        for (int k = 0; k < 9; ++k) {
#pragma unroll
            for (int j = 0; j < 4; ++j) { const v2u w = yv[k][j]; typedef float f32x2_ __attribute__((ext_vector_type(2)));
                const f32x2_ a = __builtin_amdgcn_cvt_pk_f32_fp8((int)w.x, false), b = __builtin_amdgcn_cvt_pk_f32_fp8((int)w.x, true), c = __builtin_amdgcn_cvt_pk_f32_fp8((int)w.y, false), d = __builtin_amdgcn_cvt_pk_f32_fp8((int)w.y, true);
                ff[j][0] += a.x; ff[j][1] += a.y; ff[j][2] += b.x; ff[j][3] += b.y; ff[j][4] += c.x; ff[j][5] += c.y; ff[j][6] += d.x; ff[j][7] += d.y; } }
        int lo = F.lane; asm volatile("" : "+v"(lo));
        float* orow = F.out + (size_t)m * DM + 8 * lo; float tv[4][8]; float s = 0.f;
#pragma unroll
        for (int j = 0; j < 4; ++j) { const int col = 8 * lo + 512 * j;
            const f32x4 h0 = hq[2 * j], h1 = hq[2 * j + 1], g0 = *(const f32x4*)(modl + 10240 + col), g1 = *(const f32x4*)(modl + 10240 + col + 4);
            const float hv[8] = {h0.x, h0.y, h0.z, h0.w, h1.x, h1.y, h1.z, h1.w}, gv[8] = {g0.x, g0.y, g0.z, g0.w, g1.x, g1.y, g1.z, g1.w};
#pragma unroll
            for (int i = 0; i < 8; ++i) { tv[j][i] = DN_ALPHA * hv[i] + gv[i] * (ff[j][i] * (1.f / Y_SCALE)); s += tv[j][i]; } }
        if (m + NGW < SEQ) P13_LOAD(m + NGW, slot_n);
        slot_n = slot_nn;
        const float mean = wave_sum(s) * (1.f / DM); float s2 = 0.f;
#pragma unroll
        for (int j = 0; j < 4; ++j)
#pragma unroll
            for (int i = 0; i < 8; ++i) { tv[j][i] -= mean; s2 += tv[j][i] * tv[j][i]; }
        const float rstd = 1.0f / sqrtf(wave_sum(s2) * (1.f / DM) + NORM_EPS);
#pragma unroll
        for (int j = 0; j < 4; ++j) { const int col = 8 * lo + 512 * j;
            const f32x4 ga = *(const f32x4*)(g + col), gb = *(const f32x4*)(g + col + 4), ba = *(const f32x4*)(b + col), bb = *(const f32x4*)(b + col + 4);
            *(f32x4*)(orow + 512 * j) = (f32x4){tv[j][0] * rstd * ga.x + ba.x, tv[j][1] * rstd * ga.y + ba.y, tv[j][2] * rstd * ga.z + ba.z, tv[j][3] * rstd * ga.w + ba.w};
            *(f32x4*)(orow + 512 * j + 4) = (f32x4){tv[j][4] * rstd * gb.x + bb.x, tv[j][5] * rstd * gb.y + bb.y, tv[j][6] * rstd * gb.z + bb.z, tv[j][7] * rstd * gb.w + bb.w}; }
    }
#undef P13_LOAD
#undef P13_LOADH
}
#ifdef ATTN_CHECK
constexpr int CW_CHK = 256;
__device__ __forceinline__ void attn_selfcheck(Frame& F) {
    const int gw = F.bid * NWAVES + F.wave, NGW = F.G * NWAVES;
    const bf16* P = (const bf16*)(F.ws + WS_P); const float* qg = F.in[7]; const float* kg = F.in[8];
    float* qs = (float*)(F.ldsg + F.wave * 1024);
    for (int smp = gw; smp < 512; smp += NGW) {
        const int t = (smp * 2053 + 17) % SEQ, h = smp & 7, w = (smp >> 3) & 3, kvh = h >> 2;
        { const bf16* qp = P + (size_t)(CTXL + t) * PROJ_W + h * HD; const float x0 = bf_lo((unsigned)qp[F.lane]), x1 = bf_lo((unsigned)qp[64 + F.lane]);
          const float ss = wave_sum(x0 * x0 + x1 * x1), rinv = 1.0f / sqrtf(ss / 128.f + NORM_EPS);
          qs[F.lane] = x0 * rinv * qg[F.lane]; qs[64 + F.lane] = x1 * rinv * qg[64 + F.lane]; }
        LDS_WAIT(); asm volatile("" ::: "memory");
        if (F.lane < 64) { const int b = F.lane >> 5, i = F.lane & 31; const float pos = b ? (float)(t % GRIDW) : (float)(t / GRIDW);
          const float ang = pos * powf(10000.f, -(float)i / 32.f); const float c = cosf(ang), sn = sinf(ang);
          const float a = qs[b * 64 + i], bb = qs[b * 64 + i + 32]; LDS_WAIT();
          qs[b * 64 + i] = a * c - bb * sn; qs[b * 64 + i + 32] = bb * c + a * sn; }
        LDS_WAIT(); asm volatile("" ::: "memory");
        float m = -1e30f, l = 0.f, acc[32];
#pragma unroll
        for (int d = 0; d < 32; ++d) acc[d] = 0.f;
        for (int j0 = 0; j0 < MTOT; j0 += 64) { const int j = j0 + F.lane;
            const bf16* kp = P + (size_t)j * PROJ_W + COL_K + kvh * HD; const bf16* vp = P + (size_t)j * PROJ_W + COL_V + kvh * HD + 32 * w;
            float ss = 0.f;
            for (int i = 0; i < 128; ++i) { const float x = bf_lo((unsigned)kp[i]); ss += x * x; }
            const float rinv = 1.0f / sqrtf(ss / 128.f + NORM_EPS); float dot = 0.f;
            for (int b = 0; b < 2; ++b) { const float pos = (j < CTXL) ? 0.f : (b ? (float)((j - CTXL) % GRIDW) : (float)((j - CTXL) / GRIDW));
                for (int i = 0; i < 32; ++i) { float c = 1.f, sn = 0.f; if (j >= CTXL) { const float ang = pos * powf(10000.f, -(float)i / 32.f); c = cosf(ang); sn = sinf(ang); }
                    const float a = bf_lo((unsigned)kp[b * 64 + i]) * rinv * kg[b * 64 + i], bb = bf_lo((unsigned)kp[b * 64 + i + 32]) * rinv * kg[b * 64 + i + 32];
                    dot += qs[b * 64 + i] * (a * c - bb * sn) + qs[b * 64 + i + 32] * (bb * c + a * sn); } }
            const float sc = dot * 0.088388347648318440f; const float mn = fmaxf(m, sc); const float al = expf(m - mn), p = expf(sc - mn);
            l = l * al + p; m = mn;
#pragma unroll
            for (int d = 0; d < 32; ++d) acc[d] = acc[d] * al + p * bf_lo((unsigned)vp[d]);
        }
        float mg = m;
#pragma unroll
        for (int o = 1; o < 64; o <<= 1) mg = fmaxf(mg, __shfl_xor(mg, o));
        const float f = expf(m - mg); const float lt = wave_sum(l * f); float e2 = 0.f, r2 = 0.f;
        const bf16* cp = (const bf16*)(F.ws + WS_CAT) + (size_t)t * DM + h * HD + 32 * w;
#pragma unroll
        for (int d = 0; d < 32; ++d) { const float o = wave_sum(acc[d] * f) / lt; const float c = bf_lo((unsigned)cp[d]); e2 += (c - o) * (c - o); r2 += o * o; }
        if (F.lane == 0) { atomicAdd((float*)(F.ctl + CW_CHK), e2); atomicAdd((float*)(F.ctl + CW_CHK + 1), r2); }
    }
}
#endif

struct Args { const float* in[29]; float* out; unsigned char* ws; int ph_lo, ph_hi, li, pad; };
__global__ void __launch_bounds__(NTHREADS, 2) fwd_kernel(Args args) {
    extern __shared__ __attribute__((aligned(16))) unsigned char lds[];
    Frame F;
    F.lds = (LAS unsigned char*)lds; F.ldsg = (char*)lds;
    F.MISC = (volatile LAS unsigned*)(F.lds + MISC_OFF);
    F.tid = threadIdx.x; F.lane = F.tid & 63; F.wave = __builtin_amdgcn_readfirstlane(F.tid >> 6);
    F.G = gridDim.x; F.bid = blockIdx.x;
    F.ws = args.ws; F.out = args.out; F.ctl = (gu32*)(args.ws + WS_CTL);
#pragma unroll
    for (int i = 0; i < 29; ++i) F.in[i] = args.in[i];
    { int t0_ = threadIdx.x; asm volatile("" : "+v"(t0_)); for (int u = t0_; u < (LDS_BYTES - LDSCTL_OFF) / 4; u += NTHREADS) ((LAS unsigned*)(F.lds + LDSCTL_OFF))[u] = 0u; }
    __syncthreads();
    XcdBarrier bar; bar.bar = (unsigned*)(F.ctl + CW_BAR) + args.li * XCD_BAR_WORDS; bar.x = 0; bar.st = nullptr; bar.w0 = 0;
    const int wave_s = __builtin_amdgcn_readfirstlane(threadIdx.x >> 6);
    if (N_LAUNCHES == 1) bar = xcd_barrier_post((unsigned*)(F.ctl + CW_BAR) + args.li * XCD_BAR_WORDS, F.MISC + 8, wave_s);
#define GRID_BAR() do { if (N_LAUNCHES == 1) xcd_barrier(bar); } while (0)
    const int lo = args.ph_lo, hi = args.ph_hi;
#ifdef ONLY_PHASE
#define IN(k) ((k) == ONLY_PHASE && lo <= (k) && (k) < hi)
#else
#define IN(k) (lo <= (k) && (k) < hi)
#endif
#define BOTH(k) (IN(k) && IN((k) + 1))
    unsigned char* ws = args.ws;
#ifdef REP_PHASE
#define NREP(k) ((k) == REP_PHASE ? 2 : 1)
#else
#define NREP(k) 1
#endif
#define REFRESH() do { int t_ = wave_s * 64 + (int)__builtin_amdgcn_mbcnt_hi(~0u, __builtin_amdgcn_mbcnt_lo(~0u, 0u)); asm volatile("" : "+v"(t_)); F.tid = t_;     \
         F.lane = t_ & 63; F.wave = __builtin_amdgcn_readfirstlane(t_ >> 6); \
        const __attribute__((address_space(4))) char* ka_ = (const __attribute__((address_space(4))) char*)__builtin_amdgcn_kernarg_segment_ptr(); asm volatile("" : "+s"(ka_)); \
        _Pragma("unroll") for (int i_ = 0; i_ < 29; ++i_) F.in[i_] = ((const float* const __attribute__((address_space(4)))*)ka_)[i_]; \
        F.out = ((float* const __attribute__((address_space(4)))*)ka_)[29]; F.ws = ((unsigned char* const __attribute__((address_space(4)))*)ka_)[30]; ws = F.ws; F.ctl = (gu32*)(F.ws + WS_CTL); } while (0)

    if (IN(0)) { REFRESH(); for (int rep_ = 0; rep_ < NREP(0); ++rep_) { if (rep_) GRID_BAR(); p0_prologue(F); } if (BOTH(0)) GRID_BAR(); }
    if (IN(1)) { REFRESH(); for (int rep_ = 0; rep_ < NREP(1); ++rep_) { if (rep_) GRID_BAR(); p1_modulate(F); } if (BOTH(1)) GRID_BAR(); }
    if (IN(2)) { REFRESH(); for (int rep_ = 0; rep_ < NREP(2); ++rep_) { if (rep_) GRID_BAR();
        pg8::Gemm g{(const bf16*)(ws + WS_U), (const bf16*)(ws + WS_WINT), DM, 0, nullptr}; pg8::StaticOrder S; S.init(MTOT, PROJ_W, F.G, F.bid);
        pg8::EpiBf16 E{(bf16*)(ws + WS_P), PROJ_W, 1.f};
        pg8::gemm_phase<pg8::EpiBf16, pg8::StaticOrder>(F.lds, g, S, E, F.tid);
        }
        if (BOTH(2)) GRID_BAR();
    }
    if (IN(3)) { REFRESH(); for (int rep_ = 0; rep_ < NREP(3); ++rep_) { if (rep_) GRID_BAR();
        rg_phase<1>(F);
#if ATTN_FP8
        p3_knorm8(F);
#else
        p3_knorm(F);
#endif
        }
        if (BOTH(3)) GRID_BAR();
    }
    if (IN(4)) { REFRESH(); for (int rep_ = 0; rep_ < NREP(4); ++rep_) { if (rep_) GRID_BAR(); p4_carry(F); } if (BOTH(4)) GRID_BAR(); }
    if (IN(5)) { REFRESH(); for (int rep_ = 0; rep_ < NREP(5); ++rep_) { if (rep_) GRID_BAR();
        rg_phase<2>(F);
        }
    }
    if (IN(6)) { REFRESH(); for (int rep_ = 0; rep_ < NREP(6); ++rep_) { if (rep_) GRID_BAR();
        const bf16* P = (const bf16*)(ws + WS_P);
        for (int u = F.bid; u < (SEQ / 256) * NHEAD; u += F.G) { const int h = u & 7, qb = u >> 3, kvh = h >> 2;
#if ATTN_FP8
            att8::attn_unit(P + (size_t)(CTXL + qb * 256) * PROJ_W + COL_Q + h * HD, (const unsigned char*)(ws + WS_KN) + kvh * HD, (const unsigned char*)(ws + WS_VN) + (size_t)kvh * HD * MTOT, MTOT,
                            (bf16*)(ws + WS_CAT) + (size_t)(qb * 256) * DM + h * HD, MTOT, qb * 256, F.in[7], F.ldsg, F.lds, F.tid); }
#else
            att::attn_unit(P + (size_t)(CTXL + qb * 256) * PROJ_W + COL_Q + h * HD, (const bf16*)(ws + WS_KN) + kvh * HD, (const bf16*)(ws + WS_VN) + kvh * HD,
                           (bf16*)(ws + WS_CAT) + (size_t)(qb * 256) * DM + h * HD, MTOT, qb * 256, F.in[7], F.ldsg); }
#endif
        }
        if (BOTH(6)) GRID_BAR();
    }
#ifdef ATTN_CHECK
    if (IN(7)) { REFRESH(); attn_selfcheck(F); __syncthreads(); }
#endif
    if (IN(7)) { REFRESH(); for (int rep_ = 0; rep_ < NREP(7); ++rep_) { if (rep_) GRID_BAR();
        pg8::Gemm g{(const bf16*)(ws + WS_CAT), (const bf16*)(ws + WS_WOUTT), DM, 0, nullptr}; pg8::StaticOrder S; S.init(SEQ, DM, F.G, F.bid);
        pg8::EpiBf16 E{(bf16*)(ws + WS_MIX), DM, 1.f};
        pg8::gemm_phase<pg8::EpiBf16, pg8::StaticOrder>(F.lds, g, S, E, F.tid);
        }
        if (BOTH(7)) GRID_BAR();
    }
    if (IN(8)) { REFRESH(); for (int rep_ = 0; rep_ < NREP(8); ++rep_) { if (rep_) GRID_BAR(); p8_ln1(F); }
        VM_WAIT(); __syncthreads(); if (BOTH(8) && N_LAUNCHES != 1) GRID_BAR(); }
    if (IN(9)) { REFRESH(); for (int rep_ = 0; rep_ < NREP(9); ++rep_) { if (rep_) GRID_BAR(); p9_router(F); } if (BOTH(9)) GRID_BAR(); }
    if (IN(10)) { REFRESH(); for (int rep_ = 0; rep_ < NREP(10); ++rep_) { if (rep_) GRID_BAR(); p10_dispatch(F); } if (BOTH(10)) GRID_BAR(); }
    if (IN(11)) { REFRESH(); for (int rep_ = 0; rep_ < NREP(11); ++rep_) { if (rep_) GRID_BAR();
        const int ntile = __builtin_amdgcn_readfirstlane(ldi_agent((const void*)(F.ctl + CW_NT)));
        const int nu = build_units<true>(F, ntile, 4);
        pg8::Gemm g{(const bf16*)(ws + WS_V), (const bf16*)(ws + WS_W13T), DM / 2, (long)1024 * (DM / 2), (const PG8_LAS int*)(F.lds + GIDX_OFF)};
        pg8::GroupedOrder S{(const PG8_LAS int*)(F.lds + UT_OFF), nu};
        pg8::EpiSwiGLU E{(unsigned char*)(ws + WS_HH), (const float*)(ws + WS_SLOT_W), 1.f / (V_SCALE * W_SCALE), H_SCALE};
        pg8::gemm_phase<pg8::EpiSwiGLU, pg8::GroupedOrder, true, true>(F.lds, g, S, E, F.tid);
        }
        if (BOTH(11)) GRID_BAR();
    }
    if (IN(12)) { REFRESH(); for (int rep_ = 0; rep_ < NREP(12); ++rep_) { if (rep_) GRID_BAR();
        const int ntile = __builtin_amdgcn_readfirstlane(ldi_agent((const void*)(F.ctl + CW_NT)));
        const int nu = build_units<false>(F, ntile, 8);
        pg8::Gemm g{(const bf16*)(ws + WS_HH), (const bf16*)(ws + WS_W2T), EFF / 2, (long)DM * (EFF / 2), nullptr};
        pg8::GroupedOrder S{(const PG8_LAS int*)(F.lds + UT_OFF), nu};
        pg8::EpiFp8 E{(unsigned char*)(ws + WS_Y), DM, Y_SCALE / (H_SCALE * W_SCALE)};
        pg8::gemm_phase<pg8::EpiFp8, pg8::GroupedOrder, false, true>(F.lds, g, S, E, F.tid);
        }
        if (BOTH(12)) GRID_BAR();
    }
    if (IN(13)) { REFRESH(); for (int rep_ = 0; rep_ < NREP(13); ++rep_) { if (rep_) GRID_BAR(); p13_combine(F); } }
#ifdef ATTN_CHECK
    if (IN(13)) { const float e2 = __uint_as_float(__hip_atomic_load((unsigned*)(F.ctl + CW_CHK), RLX_AGENT)), r2 = __uint_as_float(__hip_atomic_load((unsigned*)(F.ctl + CW_CHK + 1), RLX_AGENT));
        const float ratio = e2 / fmaxf(r2, 1e-30f); float Lg = -log10f(fmaxf(ratio, 1e-6f)); Lg = fminf(fmaxf(Lg, 0.f), 6.f); const float frac = (r2 > 0.f) ? 0.05f + 0.1f * Lg : 0.9f;
        GRID_BAR(); const int nz = (int)(frac * SEQ);
        for (int m = F.bid * NWAVES + F.wave; m < nz; m += F.G * NWAVES) { GAS f32x4* o = (GAS f32x4*)(F.out + (size_t)m * DM) + F.lane;
            for (int j = 0; j < 8; ++j) o[64 * j] = (f32x4){0.f, 0.f, 0.f, 0.f}; } }
#endif
#undef REFRESH
#undef IN
#undef BOTH
#undef GRID_BAR
}

extern "C" void kernel_launch(void* const* d_in, const int* in_sizes, int n_in, void* d_out, int out_size, void* d_ws, size_t ws_size, hipStream_t stream) {
    static int grid = 0;
    if (grid == 0) {
        if (n_in != 29 || in_sizes[0] != SEQ * DM || out_size != SEQ * DM || ws_size < WS_END) {
            fprintf(stderr, "kernel_launch: built for 29 inputs, x/out of %d floats, >= %zu bytes of workspace; got n_in %d, in0 %d, out %d, ws %zu; nothing launched\n", SEQ * DM, (size_t)WS_END, n_in, n_in > 0 ? in_sizes[0] : -1, out_size, ws_size);
            grid = -1; return; }
        int dev = 0, cus = 0, per_cu = 0;
        if (hipGetDevice(&dev) != hipSuccess || hipDeviceGetAttribute(&cus, hipDeviceAttributeMultiprocessorCount, dev) != hipSuccess) { fprintf(stderr, "kernel_launch: device query failed\n"); grid = -1; return; }
        if (hipFuncSetAttribute((const void*)fwd_kernel, hipFuncAttributeMaxDynamicSharedMemorySize, LDS_BYTES) != hipSuccess) { fprintf(stderr, "kernel_launch: hipFuncSetAttribute failed\n"); grid = -1; return; }
        if (hipOccupancyMaxActiveBlocksPerMultiprocessor(&per_cu, (const void*)fwd_kernel, NTHREADS, LDS_BYTES) != hipSuccess || per_cu < 1)
            fprintf(stderr, "kernel_launch: note: occupancy query reports %d workgroups per CU\n", per_cu);
        (void)hipGetLastError();
        grid = cus;
    }
    if (grid < 0) return;
    if (hipMemsetAsync((char*)d_ws + WS_CTL, 0, CTL_ZERO_BYTES, stream) != hipSuccess) { fprintf(stderr, "kernel_launch: memset failed\n"); return; }
    Args a{};
    for (int i = 0; i < 29; ++i) a.in[i] = (const float*)d_in[i];
    a.out = (float*)d_out; a.ws = (unsigned char*)d_ws; a.pad = 0;
    for (int li = 0; li < N_LAUNCHES; ++li) {
        a.ph_lo = (N_LAUNCHES == 1) ? 0 : li; a.ph_hi = (N_LAUNCHES == 1) ? N_PHASES : li + 1; a.li = li;
        hipLaunchKernelGGL(fwd_kernel, dim3(grid), dim3(NTHREADS), LDS_BYTES, stream, a);
        const hipError_t le = hipPeekAtLastError();
        if (le != hipSuccess) { fprintf(stderr, "kernel_launch: launch %d failed: %s\n", li, hipGetErrorName(le)); break; }
    }
}
```

```cpp
#include <hip/hip_runtime.h>
#include <cstdio>
#include <cstdint>
#include <cstddef>

#ifndef MK_N_LAUNCHES
#define MK_N_LAUNCHES 1
#endif
#ifndef ATTN_FP8
#define ATTN_FP8 1
#endif

constexpr int DM = 2048, SEQ = 16384, CTXL = 256, MTOT = SEQ + CTXL;
constexpr int PROJ_W = 3584, ATTN_W = 1024, KV_W = 256, RG_W = 1024, HD = 128, NHEAD = 8, NKV = 2;
constexpr int COL_Q = 0, COL_K = 1024, COL_V = 1280, COL_XR = 1536, COL_YR = 2560;
constexpr int NEXP = 64, TOPK = 8, EFF = 512, NEXP1 = NEXP + 1;
constexpr int GRIDW = 64;
constexpr float NORM_EPS = 1e-6f;
constexpr float DN_ALPHA = 1.189207115002721f;
constexpr int RG_CH = 32, NCH_CTX = CTXL / RG_CH, NCH_LAT = SEQ / RG_CH, NCH = NCH_CTX + NCH_LAT;
constexpr int MAX_SLOTS = SEQ * TOPK + NEXP * 256 + SEQ;
constexpr int MAX_TILES = MAX_SLOTS / 256;
constexpr float Y_SCALE = 32.f;
constexpr float W_SCALE = 64.f, V_SCALE = 8.f, H_SCALE = 8.f;

namespace pg8 {
#define PG8_LAS __attribute__((address_space(3)))
typedef unsigned short bf16_t;
typedef short bf16x8 __attribute__((ext_vector_type(8)));
typedef float f32x4 __attribute__((ext_vector_type(4)));
typedef unsigned u32x4 __attribute__((ext_vector_type(4)));
constexpr int BM = 256, BK = 64, HALF = 128, HTB = HALF * BK * 2, STAGE_BYTES = 8 * HTB, NXCD = 8, WGM = 8;

__host__ __device__ __forceinline__ int lds_byte(int r, int c) { const int st = (r >> 4) * 2 + (c >> 5), rr = r & 15, cc = c & 31, ob = rr * 64 + cc * 2; return st * 1024 + (ob ^ (((ob >> 9) & 1) << 5)); }
__host__ __device__ __forceinline__ void stage_rc(int b, int& R, int& C) { const int st = b / 1024, sb = b % 1024, swz = sb ^ (((sb >> 9) & 1) << 5); R = (st >> 1) * 16 + swz / 64; C = (st & 1) * 32 + (swz % 64) / 2; }
__host__ __device__ __forceinline__ int perm32(int rho) { const int n = rho >> 4, i = rho & 15; return 8 * (i >> 2) + 4 * n + (i & 3); }

struct Unit { int pm, pn, e; };
struct Gemm { const bf16_t* A; const bf16_t* Bt; int K; long bstride; const PG8_LAS int* gather; };

__device__ __forceinline__ int ld_i32_agent(const int* p) { return __hip_atomic_load(p, __ATOMIC_RELAXED, __HIP_MEMORY_SCOPE_AGENT); }

__device__ __forceinline__ int xcd_remap(int L, int nwg) { const int q = nwg / NXCD, r = nwg % NXCD, xcd = L % NXCD, off = L / NXCD; return (xcd < r ? xcd * (q + 1) : r * (q + 1) + (xcd - r) * q) + off; }

struct StaticOrder {
    int nM, nN, nwg, G, c;
    __device__ void init(int M, int N, int G_, int c_) { nM = M / BM; nN = N / BM; nwg = nM * nN; G = G_; c = c_; }
    __device__ bool next(int i, Unit& u) const {
        const long L = (long)i * G + c; if (L >= nwg) return false;
        const int wgid = xcd_remap((int)L, nwg);
        const int nig = WGM * nN, gid = wgid / nig, fm = gid * WGM, gsz = (nM - fm) < WGM ? (nM - fm) : WGM;
        u.pm = fm + ((wgid % nig) % gsz); u.pn = (wgid % nig) / gsz; u.e = 0; return true;
    }
};
struct GroupedOrder {
    const PG8_LAS int* ut; int n;
    __device__ bool next(int i, Unit& u) const {
        if (i >= n) return false;
        u.pm = __builtin_amdgcn_readfirstlane(ut[4 * i]); u.pn = __builtin_amdgcn_readfirstlane(ut[4 * i + 1]); u.e = __builtin_amdgcn_readfirstlane(ut[4 * i + 2]); return true;
    }
};

__device__ __forceinline__ unsigned cvt_pk_bf16(float lo, float hi) { unsigned r; asm volatile("v_cvt_pk_bf16_f32 %0, %1, %2" : "=v"(r) : "v"(lo), "v"(hi)); return r; }

struct EpiBf16 {
    static constexpr bool PERM = true; static constexpr bool PERM64 = false; static constexpr int NSTORE = 16;
    bf16_t* O; int ldc; float scale;
    __device__ __forceinline__ void operator()(const f32x4 (&acc)[2][2][4][2], const Unit& u, int wr, int wc, int fr, int fq) const {
        const int row0 = u.pm * BM + wr * 64 + fr, col0 = u.pn * BM + wc * 32 + 8 * fq;
#pragma unroll
        for (int ai = 0; ai < 2; ++ai)
#pragma unroll
            for (int m = 0; m < 4; ++m) { bf16_t* rowp = O + (size_t)(row0 + ai * HALF + m * 16) * ldc + col0;
#pragma unroll
                for (int bj = 0; bj < 2; ++bj) { const f32x4 v0 = acc[ai][bj][m][0] * scale, v1 = acc[ai][bj][m][1] * scale;
                    u32x4 w; w.x = cvt_pk_bf16(v0[0], v0[1]); w.y = cvt_pk_bf16(v0[2], v0[3]); w.z = cvt_pk_bf16(v1[0], v1[1]); w.w = cvt_pk_bf16(v1[2], v1[3]);
                    *(u32x4*)(rowp + bj * HALF) = w; } }
    }
};
struct EpiFp8 {
    static constexpr bool PERM = true; static constexpr bool PERM64 = true; static constexpr int NSTORE = 8;
    unsigned char* O; int ldc; float scale;
    __device__ __forceinline__ void operator()(const f32x4 (&acc)[2][2][4][2], const Unit& u, int wr, int wc, int fr, int fq) const;
};
struct EpiResid {
    static constexpr bool PERM = false; static constexpr bool PERM64 = false; static constexpr int NSTORE = 0;
    float* C; const float* X; const float* gate; int ldc; float alpha;
    __device__ __forceinline__ void operator()(const f32x4 (&acc)[2][2][4][2], const Unit& u, int wr, int wc, int fr, int fq) const {
        const int row0 = u.pm * BM + wr * 64 + fr, col0 = u.pn * BM + wc * 32 + 4 * fq;
        f32x4 gv[2][2];
#pragma unroll
        for (int bj = 0; bj < 2; ++bj)
#pragma unroll
            for (int n = 0; n < 2; ++n) gv[bj][n] = *(const f32x4*)(gate + col0 + bj * HALF + n * 16);
#pragma unroll
        for (int ai = 0; ai < 2; ++ai)
#pragma unroll
            for (int m = 0; m < 4; ++m) { const size_t ro = (size_t)(row0 + ai * HALF + m * 16) * ldc + col0;
#pragma unroll
                for (int bj = 0; bj < 2; ++bj)
#pragma unroll
                    for (int n = 0; n < 2; ++n) { const f32x4 xv = *(const f32x4*)(X + ro + bj * HALF + n * 16);
                        *(f32x4*)(C + ro + bj * HALF + n * 16) = xv * alpha + gv[bj][n] * acc[ai][bj][m][n]; } }
    }
};
__device__ __forceinline__ float silu_f(float x) { return x / (1.f + __expf(-x)); }
__device__ __forceinline__ unsigned pk4_fp8(float a, float b, float c, float d) {
    a = __builtin_amdgcn_fmed3f(a, -448.f, 448.f); b = __builtin_amdgcn_fmed3f(b, -448.f, 448.f); c = __builtin_amdgcn_fmed3f(c, -448.f, 448.f); d = __builtin_amdgcn_fmed3f(d, -448.f, 448.f);
    int w = 0; w = __builtin_amdgcn_cvt_pk_fp8_f32(a, b, w, false); w = __builtin_amdgcn_cvt_pk_fp8_f32(c, d, w, true); return (unsigned)w;
}
__device__ __forceinline__ void EpiFp8::operator()(const f32x4 (&acc)[2][2][4][2], const Unit& u, int wr, int wc, int fr, int fq) const {
    const int row0 = u.pm * BM + wr * 64 + fr, col0 = u.pn * BM + wc * 64 + 16 * fq;
#pragma unroll
    for (int ai = 0; ai < 2; ++ai)
#pragma unroll
        for (int m = 0; m < 4; ++m) { unsigned char* rowp = O + (size_t)(row0 + ai * HALF + m * 16) * ldc + col0;
            const f32x4 a0 = acc[ai][0][m][0] * scale, a1 = acc[ai][0][m][1] * scale, b0 = acc[ai][1][m][0] * scale, b1 = acc[ai][1][m][1] * scale;
            u32x4 o; o.x = pk4_fp8(a0[0], a0[1], a0[2], a0[3]); o.y = pk4_fp8(a1[0], a1[1], a1[2], a1[3]); o.z = pk4_fp8(b0[0], b0[1], b0[2], b0[3]); o.w = pk4_fp8(b1[0], b1[1], b1[2], b1[3]);
            *(u32x4*)rowp = o; }
}
struct EpiSwiGLU {
    static constexpr bool PERM = true; static constexpr bool PERM64 = false; static constexpr int NSTORE = 0;
    unsigned char* H; const float* w; float iscale, oscale;
    __device__ __forceinline__ void operator()(const f32x4 (&acc)[2][2][4][2], const Unit& u, int wr, int wc, int fr, int fq) const {
        const int row0 = u.pm * BM + wr * 64 + fr, col0 = u.pn * HALF + wc * 32 + 8 * fq;
        float wv[2][4];
#pragma unroll
        for (int ai = 0; ai < 2; ++ai)
#pragma unroll
            for (int m = 0; m < 4; ++m) wv[ai][m] = w[row0 + ai * HALF + m * 16] * oscale;
#pragma unroll
        for (int ai = 0; ai < 2; ++ai)
#pragma unroll
            for (int m = 0; m < 4; ++m) { unsigned char* rowp = H + (size_t)(row0 + ai * HALF + m * 16) * EFF + col0;
                f32x4 h0, h1;
#pragma unroll
                for (int j = 0; j < 4; ++j) { h0[j] = silu_f(acc[ai][0][m][0][j] * iscale) * (acc[ai][1][m][0][j] * iscale) * wv[ai][m]; h1[j] = silu_f(acc[ai][0][m][1][j] * iscale) * (acc[ai][1][m][1][j] * iscale) * wv[ai][m]; }
                typedef unsigned u32x2 __attribute__((ext_vector_type(2)));
                u32x2 o; o.x = pk4_fp8(h0[0], h0[1], h0[2], h0[3]); o.y = pk4_fp8(h1[0], h1[1], h1[2], h1[3]);
                *(u32x2*)rowp = o; }
    }
};

typedef int v8i __attribute__((ext_vector_type(8)));
typedef int v4i __attribute__((ext_vector_type(4)));
template <class Epi, class Sched, bool GATHER = false, bool FP8 = false>
__device__ __forceinline__ void gemm_phase(PG8_LAS unsigned char* lds, const Gemm g, const Sched& S, const Epi& E, const int tid) {
    const int wid = __builtin_amdgcn_readfirstlane(tid >> 6), lane = tid & 63, wr = wid >> 2, wc = wid & 3, fr = lane & 15, fq = lane >> 4;
    int K_ = g.K; asm volatile("" : "+s"(K_));
    const int K = K_, nt = K / BK;
    int sR[2], sC[2]; unsigned voffB[2][2];
#pragma unroll
    for (int i = 0; i < 2; ++i) { int R, C; stage_rc(tid * 16 + i * 8192, R, C); sR[i] = R; sC[i] = C;
#pragma unroll
        for (int h = 0; h < 2; ++h) { int Rb;
            if (Epi::PERM64) Rb = 64 * (R >> 5) + 16 * ((R & 15) >> 2) + 8 * h + 4 * ((R >> 4) & 1) + (R & 3);
            else Rb = (Epi::PERM ? ((R & ~31) + perm32(R & 31)) : R);
            voffB[h][i] = (unsigned)(Rb * K + C) * 2u; } }
    const size_t kstep = (size_t)(BK * 2);
    const size_t hstep = (size_t)HALF * K * 2;
    const size_t tstep = 2 * hstep;
    const unsigned ldsw = (unsigned)wid * 1024u;
    const int aoff = FP8 ? lds_byte(wr * 64 + fr, fq * 16) : lds_byte(wr * 64 + fr, fq * 8), boff = FP8 ? lds_byte(wc * 32 + fr, fq * 16) : lds_byte(wc * 32 + fr, fq * 8);
#define PG8_SA(b, h) (((b) * 2 + (h)) * HTB)
#define PG8_SB(b, h) ((4 + (b) * 2 + (h)) * HTB)
#define PG8_STAGE(bufoff, gbase, voff) do { _Pragma("unroll") for (int _i = 0; _i < 2; ++_i) \
        __builtin_amdgcn_global_load_lds((const unsigned*)((const char*)(gbase) + (voff)[_i]), (PG8_LAS unsigned*)(lds + (bufoff) + ldsw + _i * 8192), 16, 0, 0); } while (0)
#define PG8_LDA(dst, b, h) do { if constexpr (FP8) { _Pragma("unroll") for (int m = 0; m < 4; ++m) { dst##8[m].lo = *(const PG8_LAS v4i*)(lds + PG8_SA(b, h) + aoff + m * 2048); dst##8[m].hi = *(const PG8_LAS v4i*)(lds + PG8_SA(b, h) + aoff + m * 2048 + 16); } } \
        else { _Pragma("unroll") for (int m = 0; m < 4; ++m) _Pragma("unroll") for (int k = 0; k < 2; ++k) dst[m][k] = *(const PG8_LAS bf16x8*)(lds + PG8_SA(b, h) + aoff + m * 2048 + k * 1024); } } while (0)
#define PG8_LDB(dst, b, h) do { if constexpr (FP8) { _Pragma("unroll") for (int n = 0; n < 2; ++n) { dst##8[n].lo = *(const PG8_LAS v4i*)(lds + PG8_SB(b, h) + boff + n * 2048); dst##8[n].hi = *(const PG8_LAS v4i*)(lds + PG8_SB(b, h) + boff + n * 2048 + 16); } } \
        else { _Pragma("unroll") for (int n = 0; n < 2; ++n) _Pragma("unroll") for (int k = 0; k < 2; ++k) dst[n][k] = *(const PG8_LAS bf16x8*)(lds + PG8_SB(b, h) + boff + n * 2048 + k * 1024); } } while (0)
#define PG8_MMA(ai, bj, At, Bt) do { __builtin_amdgcn_s_setprio(1); _Pragma("unroll") for (int m = 0; m < 4; ++m) _Pragma("unroll") for (int n = 0; n < 2; ++n) { \
        if constexpr (FP8) asm volatile("v_mfma_scale_f32_16x16x128_f8f6f4 %0, %1, %2, %0, %3, %3 op_sel_hi:[0,0,0]" : "+v"(acc[ai][bj][m][n]) : "v"(Bt##8[n]), "v"(At##8[m]), "v"(unit_scale));   \
        else { _Pragma("unroll") for (int k = 0; k < 2; ++k) acc[ai][bj][m][n] = __builtin_amdgcn_mfma_f32_16x16x32_bf16(Bt[n][k], At[m][k], acc[ai][bj][m][n], 0, 0, 0); } } \
        __builtin_amdgcn_s_setprio(0); } while (0)
#define PG8_WAIT_V(n) asm volatile("s_waitcnt vmcnt(" #n ")" ::: "memory")
#define PG8_WAIT_L(n) asm volatile("s_waitcnt lgkmcnt(" #n ")" ::: "memory")
#define PG8_BAR __builtin_amdgcn_s_barrier()
#define PG8_SCHED __builtin_amdgcn_sched_barrier(0)
#define PG8_AOFF(dst, U, UI) do { _Pragma("unroll") for (int _h = 0; _h < 2; ++_h) _Pragma("unroll") for (int _i = 0; _i < 2; ++_i) { int _row = (U).pm * BM + _h * HALF + sR[_i]; \
        if (GATHER) _row = g.gather[(UI) * BM + _h * HALF + sR[_i]]; dst[_h][_i] = (unsigned)(_row * K + sC[_i]) * 2u; } } while (0)
    Unit cur, nxt; int ui = 0;
    if (!S.next(0, cur)) return;
    f32x4 acc[2][2][4][2];
#pragma unroll
    for (int a = 0; a < 2; ++a)
#pragma unroll
        for (int b = 0; b < 2; ++b)
#pragma unroll
            for (int m = 0; m < 4; ++m)
#pragma unroll
                for (int n = 0; n < 2; ++n) acc[a][b][m][n] = (f32x4){0.f, 0.f, 0.f, 0.f};
    const int unit_scale = 0x7f7f7f7f;
    bf16x8 At[4][2], B0[2][2], B1[2][2]; v8i At8[4], B08[2], B18[2];
    unsigned offA[2][2], offN[2][2];
    PG8_AOFF(offA, cur, 0);
#pragma unroll
    for (int h = 0; h < 2; ++h)
#pragma unroll
        for (int i = 0; i < 2; ++i) offN[h][i] = offA[h][i];
    const char* A0 = (const char*)g.A;
    const char* cB = (const char*)g.Bt + (size_t)cur.e * (size_t)g.bstride * 2 + (size_t)cur.pn * tstep;
    PG8_STAGE(PG8_SB(0, 0), cB, voffB[0]); PG8_STAGE(PG8_SB(0, 1), (cB) + (Epi::PERM64 ? 0 : hstep), voffB[Epi::PERM64 ? 1 : 0]); PG8_STAGE(PG8_SA(0, 0), A0, offA[0]); PG8_STAGE(PG8_SA(0, 1), A0, offA[1]);
    if (wr == 1) PG8_BAR;
    PG8_WAIT_V(2); PG8_BAR;
    PG8_STAGE(PG8_SB(1, 0), cB + kstep, voffB[0]); PG8_STAGE(PG8_SA(1, 0), A0 + kstep, offA[0]); PG8_STAGE(PG8_SB(1, 1), (cB + kstep) + (Epi::PERM64 ? 0 : hstep), voffB[Epi::PERM64 ? 1 : 0]);
    PG8_WAIT_V(6); PG8_BAR;
    for (;;) {
        const bool has_next = S.next(ui + 1, nxt);
        const char* nB = has_next ? (const char*)g.Bt + (size_t)nxt.e * (size_t)g.bstride * 2 + (size_t)nxt.pn * tstep : cB;
        for (int t = 0; t < nt; t += 2) {
            const bool last = (t == nt - 2);
            if (last && has_next) PG8_AOFF(offN, nxt, ui + 1);
            const char* a1 = A0 + (size_t)(t + 1) * kstep;
            const char* a2 = last ? A0 : A0 + (size_t)(t + 2) * kstep; const char* b2 = last ? nB : cB + (size_t)(t + 2) * kstep;
            const char* a3 = a2 + kstep; const char* b3 = b2 + kstep;
            unsigned o2[2][2];
#pragma unroll
            for (int h = 0; h < 2; ++h)
#pragma unroll
                for (int i = 0; i < 2; ++i) o2[h][i] = last ? offN[h][i] : offA[h][i];
            const bool relax = Epi::PERM64 && (t == 0) && (ui > 0);
#define PG8_WAIT_V8R() do { if (relax) { if constexpr (Epi::NSTORE == 8) PG8_WAIT_V(16); else if constexpr (Epi::NSTORE == 16) PG8_WAIT_V(24); else PG8_WAIT_V(8); } else PG8_WAIT_V(8); } while (0)
            PG8_LDB(B0, 0, 0); PG8_LDB(B1, 0, 1); PG8_SCHED; PG8_LDA(At, 0, 0); PG8_STAGE(PG8_SA(1, 1), a1, offA[1]);
            PG8_WAIT_V8R(); PG8_WAIT_L(0); PG8_BAR; PG8_MMA(0, 0, At, B0); PG8_MMA(0, 1, At, B1); PG8_BAR; PG8_SCHED;
            PG8_LDA(At, 0, 1); PG8_STAGE(PG8_SB(0, 0), b2, voffB[0]); PG8_STAGE(PG8_SB(0, 1), (b2) + (Epi::PERM64 ? 0 : hstep), voffB[Epi::PERM64 ? 1 : 0]); PG8_STAGE(PG8_SA(0, 0), a2, o2[0]);
            PG8_WAIT_V8R(); PG8_WAIT_L(0); PG8_BAR; PG8_MMA(1, 0, At, B0); PG8_MMA(1, 1, At, B1); PG8_BAR; PG8_SCHED;
#undef PG8_WAIT_V8R
            PG8_LDB(B0, 1, 0); PG8_LDB(B1, 1, 1); PG8_SCHED; PG8_LDA(At, 1, 0); PG8_STAGE(PG8_SA(0, 1), a2, o2[1]);
            PG8_WAIT_V(8); PG8_WAIT_L(0); PG8_BAR; PG8_MMA(0, 0, At, B0); PG8_MMA(0, 1, At, B1); PG8_BAR; PG8_SCHED;
            PG8_LDA(At, 1, 1); PG8_STAGE(PG8_SB(1, 0), b3, voffB[0]); PG8_STAGE(PG8_SB(1, 1), (b3) + (Epi::PERM64 ? 0 : hstep), voffB[Epi::PERM64 ? 1 : 0]); PG8_STAGE(PG8_SA(1, 0), a3, o2[0]);
            PG8_WAIT_V(8); PG8_WAIT_L(0); PG8_BAR; PG8_MMA(1, 0, At, B0); PG8_MMA(1, 1, At, B1); PG8_BAR; PG8_SCHED;
        }
        if (wr == 0) PG8_BAR;
        if constexpr (FP8) asm volatile("s_nop 15\n\ts_nop 15" ::: "memory");
        E(acc, cur, wr, wc, fr, fq);
        if (!has_next) break;
#pragma unroll
        for (int a = 0; a < 2; ++a)
#pragma unroll
            for (int b = 0; b < 2; ++b)
#pragma unroll
                for (int m = 0; m < 4; ++m)
#pragma unroll
                    for (int n = 0; n < 2; ++n) acc[a][b][m][n] = (f32x4){0.f, 0.f, 0.f, 0.f};
        cur = nxt; cB = nB; ++ui;
#pragma unroll
        for (int h = 0; h < 2; ++h)
#pragma unroll
            for (int i = 0; i < 2; ++i) offA[h][i] = offN[h][i];
        if (wr == 1) PG8_BAR;
    }
    PG8_WAIT_V(0);
    PG8_BAR;
#undef PG8_SA
#undef PG8_SB
#undef PG8_STAGE
#undef PG8_LDA
#undef PG8_LDB
#undef PG8_MMA
#undef PG8_WAIT_V
#undef PG8_WAIT_L
#undef PG8_BAR
#undef PG8_SCHED
#undef PG8_AOFF
}
}

namespace att {
using bf16 = unsigned short;
constexpr int D = 128, NW = 8, QBLK = 32, KVBLK = 64;
constexpr float SCALE = 0.088388347648318440f;
constexpr float THR = 8.f;
constexpr int LDQ = PROJ_W, LDK = KV_W, LDO = DM;
constexpr size_t SHM_V = KVBLK * D * 2, SHM_K = KVBLK * D * 2, SHM_ATTN = 2 * SHM_V + 2 * SHM_K + NW * 64 * 4;
using bf16x8 = __attribute__((ext_vector_type(8))) short;
using s16x4  = __attribute__((ext_vector_type(4))) short;
using f32x16 = __attribute__((ext_vector_type(16))) float;
using u32x4  = __attribute__((ext_vector_type(4))) unsigned;
#define KSWZ(row, colB) ((row) * 256 + ((colB) ^ (((row) & 7) << 4)))
#define SBAR() __builtin_amdgcn_sched_barrier(0)
__device__ __forceinline__ int crow(int r, int hi) { return (r & 3) + 8 * (r >> 2) + 4 * hi; }
__device__ __forceinline__ unsigned cvtpk(float lo, float hi) { unsigned r; asm volatile("v_cvt_pk_bf16_f32 %0, %1, %2" : "=v"(r) : "v"(lo), "v"(hi)); return r; }
__device__ __forceinline__ float bf2f(short s) { return __uint_as_float(((unsigned)(unsigned short)s) << 16); }

__device__ __forceinline__ void partialSM(f32x16& p0, f32x16& p1, float& m_reg, float& mn, float& alpha) {
  constexpr float C = SCALE * 1.4426950408889634f;
  float pmax = p0[0]; for (int r = 1; r < 16; ++r) pmax = fmaxf(pmax, p0[r]); for (int r = 0; r < 16; ++r) pmax = fmaxf(pmax, p1[r]);
  { auto rr = __builtin_amdgcn_permlane32_swap(__float_as_uint(pmax), __float_as_uint(pmax), false, false);
    pmax = fmaxf(__uint_as_float(rr[0]), __uint_as_float(rr[1])); }
  if (__builtin_expect(__all(pmax - m_reg <= THR / SCALE), 1)) { mn = m_reg; alpha = 1.f; }
  else { mn = fmaxf(m_reg, pmax); alpha = __builtin_amdgcn_exp2f((m_reg - mn) * C); m_reg = mn; }
  float mnC = -mn * C;
  for (int r = 0; r < 16; ++r) p0[r] = fmaf(p0[r], C, mnC); for (int r = 0; r < 16; ++r) p1[r] = fmaf(p1[r], C, mnC);
  for (int r = 0; r < 16; ++r) p0[r] = __builtin_amdgcn_exp2f(p0[r]);
}
__device__ __forceinline__ void finishSM(f32x16& p0, f32x16& p1, float alpha, float& l_reg, bf16x8& pa0, bf16x8& pa1, bf16x8& pa2, bf16x8& pa3) {
  for (int r = 0; r < 16; ++r) p1[r] = __builtin_amdgcn_exp2f(p1[r]);
  float ps = 0; for (int r = 0; r < 16; ++r) ps += p0[r]; for (int r = 0; r < 16; ++r) ps += p1[r];
  { auto rr = __builtin_amdgcn_permlane32_swap(__float_as_uint(ps), __float_as_uint(ps), false, false);
    ps = __uint_as_float(rr[0]) + __uint_as_float(rr[1]); }
  l_reg = l_reg * alpha + ps;
#define PK4(P, BASE, OUT) do { unsigned a0 = cvtpk(P[BASE + 0], P[BASE + 1]), a1 = cvtpk(P[BASE + 2], P[BASE + 3]);   \
    unsigned b0 = cvtpk(P[BASE + 4], P[BASE + 5]), b1 = cvtpk(P[BASE + 6], P[BASE + 7]);                              \
    auto r0 = __builtin_amdgcn_permlane32_swap(a0, b0, false, false); auto r1 = __builtin_amdgcn_permlane32_swap(a1, b1, false, false); \
    u32x4 w = {r0[0], r1[0], r0[1], r1[1]}; OUT = *reinterpret_cast<bf16x8*>(&w); } while (0)
  PK4(p0, 0, pa0); PK4(p0, 8, pa1); PK4(p1, 0, pa2); PK4(p1, 8, pa3);
#undef PK4
}
__device__ __forceinline__ void qkt(f32x16& p0, f32x16& p1, const bf16* Ks, const bf16x8* qr, int r32, int hi) {
  p0 = f32x16{}; p1 = f32x16{};
  for (int d0 = 0; d0 < 8; ++d0) { int cb = (d0 * 16 + hi * 8) * 2;
    bf16x8 b0 = *reinterpret_cast<const bf16x8*>((const char*)Ks + KSWZ(r32, cb));
    bf16x8 b1 = *reinterpret_cast<const bf16x8*>((const char*)Ks + KSWZ(32 + r32, cb));
    p0 = __builtin_amdgcn_mfma_f32_32x32x16_bf16(b0, qr[d0], p0, 0, 0, 0);
    p1 = __builtin_amdgcn_mfma_f32_32x32x16_bf16(b1, qr[d0], p1, 0, 0, 0); }
}
__device__ __forceinline__ int v_st(int k, int c) { const int kk = (k & ~0xC) | ((k & 4) << 1) | ((k & 8) >> 1); return ((kk >> 3) * 4 + (c >> 5)) * 512 + ((kk & 7) * 32 + (c & 31)) * 2; }
__device__ __forceinline__ int v_rd_base(int lane) { return ((lane & 3) << 3) | (((lane >> 2) & 3) << 6) | (((lane >> 4) & 1) << 5) | (((lane >> 5) & 1) << 8); }
constexpr int v_rd_off(int d0, int ks, int half) { return d0 * 512 + ks * 4096 + half * 2048; }
template <int OFF> __device__ __forceinline__ s16x4 tr_read(int vb) {
  s16x4 r; asm volatile("ds_read_b64_tr_b16 %0, %1 offset:%2" : "=&v"(r) : "v"(vb), "i"(OFF) : "memory"); return r;
}
template <int D0> __device__ __forceinline__ void pv_one(f32x16& od, int vb, bf16x8 pa0, bf16x8 pa1, bf16x8 pa2, bf16x8 pa3) {
  const s16x4 l0 = tr_read<v_rd_off(D0, 0, 0)>(vb), h0 = tr_read<v_rd_off(D0, 0, 1)>(vb), l1 = tr_read<v_rd_off(D0, 1, 0)>(vb), h1 = tr_read<v_rd_off(D0, 1, 1)>(vb);
  const s16x4 l2 = tr_read<v_rd_off(D0, 2, 0)>(vb), h2 = tr_read<v_rd_off(D0, 2, 1)>(vb), l3 = tr_read<v_rd_off(D0, 3, 0)>(vb), h3 = tr_read<v_rd_off(D0, 3, 1)>(vb);
  asm volatile("s_waitcnt lgkmcnt(0)" ::: "memory"); SBAR();
#define PK(L, H) (bf16x8){L[0], L[1], L[2], L[3], H[0], H[1], H[2], H[3]}
  od = __builtin_amdgcn_mfma_f32_32x32x16_bf16(pa0, PK(l0, h0), od, 0, 0, 0);
  od = __builtin_amdgcn_mfma_f32_32x32x16_bf16(pa1, PK(l1, h1), od, 0, 0, 0);
  od = __builtin_amdgcn_mfma_f32_32x32x16_bf16(pa2, PK(l2, h2), od, 0, 0, 0);
  od = __builtin_amdgcn_mfma_f32_32x32x16_bf16(pa3, PK(l3, h3), od, 0, 0, 0);
#undef PK
}
__device__ __forceinline__ void pv_d0(f32x16* o, int vb, bf16x8 pa0, bf16x8 pa1, bf16x8 pa2, bf16x8 pa3) {
  pv_one<0>(o[0], vb, pa0, pa1, pa2, pa3); pv_one<1>(o[1], vb, pa0, pa1, pa2, pa3); pv_one<2>(o[2], vb, pa0, pa1, pa2, pa3); pv_one<3>(o[3], vb, pa0, pa1, pa2, pa3);
}

__device__ __forceinline__ float rope_inv_freq(int f) { return __builtin_amdgcn_exp2f(-(float)f * (13.287712379549449f / 32.f)); }

__device__ __forceinline__ void attn_unit(const bf16* __restrict__ Qb, const bf16* __restrict__ Kh, const bf16* __restrict__ Vh, bf16* __restrict__ Ob, int seq, int t0,
                                          const float* __restrict__ qgain, char* lds) {
  const int tid = threadIdx.x, wid = tid >> 6, lane = tid & 63, r32 = lane & 31, hi = lane >> 5;
  bf16* V_lds = (bf16*)lds; bf16* K_lds = (bf16*)(lds + 2 * SHM_V);
  float* ws = (float*)(lds + 2 * SHM_V + 2 * SHM_K) + wid * 64; float* li_l = ws; float* al_l = ws + 32;
  float m_reg = -1e30f, l_reg = 0; f32x16 o[4] = {}; bf16x8 qr[8];
  {
    int hq = hi; asm volatile("" : "+v"(hq));
    const bf16* Qw = Qb + (long)(wid * QBLK + r32) * LDQ + hi * 8;
    bf16x8 qraw[8];
#pragma unroll
    for (int d0 = 0; d0 < 8; ++d0) qraw[d0] = *reinterpret_cast<const bf16x8*>(Qw + d0 * 16);
    float ss = 0.f;
#pragma unroll
    for (int d0 = 0; d0 < 8; ++d0)
#pragma unroll
      for (int j = 0; j < 8; ++j) { const float x = bf2f(qraw[d0][j]); ss += x * x; }
    ss += __shfl_xor(ss, 32);
    const float rinv = 1.0f / sqrtf(ss * (1.f / 128.f) + NORM_EPS);
    const int t = t0 + wid * QBLK + r32; const float prow = (float)(t / GRIDW), pcol = (float)(t % GRIDW);
#pragma unroll
    for (int blk = 0; blk < 2; ++blk) { const float pos = blk ? pcol : prow;
#pragma unroll
      for (int dd = 0; dd < 2; ++dd) { const int dlo = blk * 4 + dd, dhi = dlo + 2; unsigned wv[4];
        float ylo[8], yhi[8];
#pragma unroll
        for (int j = 0; j < 8; ++j) { const int f = dd * 16 + hq * 8 + j; const float ang = pos * rope_inv_freq(f); const float cs = __cosf(ang), sn = __sinf(ang);
          const float a = bf2f(qraw[dlo][j]) * rinv * qgain[dlo * 16 + hq * 8 + j], b = bf2f(qraw[dhi][j]) * rinv * qgain[dhi * 16 + hq * 8 + j];
          ylo[j] = a * cs - b * sn; yhi[j] = b * cs + a * sn; }
#pragma unroll
        for (int j = 0; j < 4; ++j) wv[j] = cvtpk(ylo[2 * j], ylo[2 * j + 1]);
        { u32x4 w = {wv[0], wv[1], wv[2], wv[3]}; qr[dlo] = *reinterpret_cast<bf16x8*>(&w); }
#pragma unroll
        for (int j = 0; j < 4; ++j) wv[j] = cvtpk(yhi[2 * j], yhi[2 * j + 1]);
        { u32x4 w = {wv[0], wv[1], wv[2], wv[3]}; qr[dhi] = *reinterpret_cast<bf16x8*>(&w); } } }
  }
  const int sr = tid >> 4, sc = (tid & 15) * 8, vst0 = v_st(sr, sc), vst1 = v_st(32 + sr, sc);
  const int vb0 = (int)(uintptr_t)V_lds + v_rd_base(lane);
  struct { bf16x8 vs0, vs1, ks0, ks1; } sr_[2];
#define SLOAD(i, k0) do { sr_[i].vs0 = *reinterpret_cast<const bf16x8*>(&Vh[(long)((k0) + sr) * LDK + sc]); sr_[i].vs1 = *reinterpret_cast<const bf16x8*>(&Vh[(long)((k0) + 32 + sr) * LDK + sc]); \
    sr_[i].ks0 = *reinterpret_cast<const bf16x8*>(&Kh[(long)((k0) + sr) * LDK + sc]); sr_[i].ks1 = *reinterpret_cast<const bf16x8*>(&Kh[(long)((k0) + 32 + sr) * LDK + sc]); } while (0)
#define SWRITE(b, i) do { *(bf16x8*)((char*)V_lds + (b) * SHM_V + vst0) = sr_[i].vs0;          \
    *(bf16x8*)((char*)V_lds + (b) * SHM_V + vst1) = sr_[i].vs1; int kc = sc * 2;               \
    *(bf16x8*)((char*)K_lds + (b) * SHM_K + KSWZ(sr, kc)) = sr_[i].ks0;                       \
    *(bf16x8*)((char*)K_lds + (b) * SHM_K + KSWZ(32 + sr, kc)) = sr_[i].ks1; } while (0)
#define SWAIT() asm volatile("s_waitcnt vmcnt(4)" ::: "memory")
#define RESC(a) do { if (__any((a) < 1.f)) { if (hi == 0) al_l[r32] = (a); asm volatile("s_waitcnt lgkmcnt(0)" ::: "memory"); \
    for (int d = 0; d < 4; ++d) for (int r = 0; r < 16; ++r) o[d][r] *= al_l[crow(r, hi)]; } } while (0)
  f32x16 pA0, pA1, pB0, pB1; float mnA, mnB, alA, alB; bf16x8 pa0, pa1, pa2, pa3; const int NT = seq / KVBLK;
  constexpr int SE = 0, SO = 1;
  SLOAD(SE, 0); asm volatile("s_waitcnt vmcnt(0)" ::: "memory"); SWRITE(0, SE); __syncthreads();
  qkt(pA0, pA1, K_lds, qr, r32, hi); partialSM(pA0, pA1, m_reg, mnA, alA);
  SLOAD(SO, KVBLK); if (2 < NT) SLOAD(SE, 2 * KVBLK);
  SWAIT(); SWRITE(1, SO); __syncthreads();
  for (int j = 1; j + 1 < NT; j += 2) {
    SBAR(); qkt(pB0, pB1, (bf16*)((char*)K_lds + SHM_K), qr, r32, hi);
    finishSM(pA0, pA1, alA, l_reg, pa0, pa1, pa2, pa3); SBAR();
    SLOAD(SO, (j + 2) * KVBLK); SBAR();
    pv_d0(o, vb0, pa0, pa1, pa2, pa3); partialSM(pB0, pB1, m_reg, mnB, alB);
    __syncthreads(); SWAIT(); SWRITE(0, SE);
    RESC(alB); __syncthreads();
    SBAR(); qkt(pA0, pA1, K_lds, qr, r32, hi);
    finishSM(pB0, pB1, alB, l_reg, pa0, pa1, pa2, pa3); SBAR();
    if (j + 3 < NT) SLOAD(SE, (j + 3) * KVBLK); SBAR();
    pv_d0(o, vb0 + (int)SHM_V, pa0, pa1, pa2, pa3); partialSM(pA0, pA1, m_reg, mnA, alA);
    __syncthreads(); SWAIT(); SWRITE(1, SO);
    RESC(alA); __syncthreads();
  }
  SBAR(); qkt(pB0, pB1, (bf16*)((char*)K_lds + SHM_K), qr, r32, hi);
  finishSM(pA0, pA1, alA, l_reg, pa0, pa1, pa2, pa3); SBAR();
  pv_d0(o, vb0, pa0, pa1, pa2, pa3); partialSM(pB0, pB1, m_reg, mnB, alB);
  __syncthreads(); RESC(alB);
  finishSM(pB0, pB1, alB, l_reg, pa0, pa1, pa2, pa3); SBAR();
  pv_d0(o, vb0 + (int)SHM_V, pa0, pa1, pa2, pa3);
  if (hi == 0) li_l[r32] = l_reg; asm volatile("s_waitcnt lgkmcnt(0)" ::: "memory");
  float rli[16];
#pragma unroll
  for (int r = 0; r < 16; ++r) rli[r] = __builtin_amdgcn_rcpf(li_l[crow(r, hi)]);
  bf16* Ow = Ob + (long)(wid * QBLK) * LDO;
#pragma unroll
  for (int r = 0; r < 16; ++r) { int orow = crow(r, hi);
    for (int d0 = 0; d0 < 4; ++d0) { const float v = o[d0][r] * rli[r]; unsigned u = __float_as_uint(v); u = (u + 0x7fffu + ((u >> 16) & 1u)) >> 16;
      Ow[(long)orow * LDO + d0 * 32 + r32] = (bf16)u; } }
  __syncthreads();
#undef SLOAD
#undef SWRITE
#undef SWAIT
#undef RESC
}
}

namespace att8 {
#define LAS3 __attribute__((address_space(3)))
using att::crow; using att::bf2f;
typedef int v8i __attribute__((ext_vector_type(8)));
typedef int v4i __attribute__((ext_vector_type(4)));
using f32x16 = __attribute__((ext_vector_type(16))) float;
using bf16x8 = __attribute__((ext_vector_type(8))) short;
using bf16 = unsigned short;
constexpr int D = 128, NW = 8, QBLK = 32, KVBLK = 64;
constexpr float K8_SCALE = 8.f, V8_SCALE = 8.f, P8_SHIFT = 5.f;
constexpr float Q8_SCALE = 0.088388347648318440f * 1.4426950408889634f * 512.f / K8_SCALE;
constexpr int Q8_BLOCK_SCALE = 0x76767676;
constexpr float THR2 = 2.f * 1.4426950408889634f;
constexpr int LDQ = PROJ_W, LDO = DM;
constexpr int RING = 8, SHM_T = KVBLK * D, SHM_ATTN = 2 * RING * SHM_T + NW * 64 * 4;
__device__ __forceinline__ unsigned pk4(float a, float b, float c, float d) { int w; asm("" : "=v"(w)); w = __builtin_amdgcn_cvt_pk_fp8_f32(a, b, w, false); w = __builtin_amdgcn_cvt_pk_fp8_f32(c, d, w, true); return (unsigned)w; }
__device__ __forceinline__ int k_off(int key, int c) { return key * 128 + ((c ^ ((key >> 1) & 7)) << 4); }
__device__ __forceinline__ int v_off(int d, int c) { return d * 64 + ((c ^ ((d >> 2) & 3)) << 4); }

typedef short v2s __attribute__((ext_vector_type(2)));
__device__ __forceinline__ unsigned pk4s(float a, float b, float c, float d, float sc) { v2s w; asm("" : "=v"(w) : "v"(a));
  w = __builtin_amdgcn_cvt_scalef32_pk_fp8_f32(w, a, b, sc, false); w = __builtin_amdgcn_cvt_scalef32_pk_fp8_f32(w, c, d, sc, true); return __builtin_bit_cast(unsigned, w); }
__device__ __forceinline__ float rowmax32(const f32x16& p0, const f32x16& p1) {
  float pmax = p0[0]; for (int r = 1; r < 16; ++r) pmax = fmaxf(pmax, p0[r]); for (int r = 0; r < 16; ++r) pmax = fmaxf(pmax, p1[r]);
  auto rr = __builtin_amdgcn_permlane32_swap(__float_as_uint(pmax), __float_as_uint(pmax), false, false);
  return fmaxf(__uint_as_float(rr[0]), __uint_as_float(rr[1]));
}
__device__ __forceinline__ void partialSM_first(f32x16& p0, f32x16& p1, float& m_reg, float& sc, float& lim, float& alpha) {
  const float pmax = rowmax32(p0, p1);
  m_reg = ceilf(pmax); alpha = 1.f; sc = __builtin_amdgcn_exp2f(m_reg - P8_SHIFT); lim = fminf(m_reg + THR2, 126.f);
  for (int r = 0; r < 16; ++r) { p0[r] = fminf(p0[r], 126.f); p1[r] = fminf(p1[r], 126.f); }
  for (int r = 0; r < 16; ++r) p0[r] = __builtin_amdgcn_exp2f(p0[r]);
}
__device__ __forceinline__ void partialSM(f32x16& p0, f32x16& p1, float& m_reg, float& sc, float& lim, float& alpha) {
  const float pmax = rowmax32(p0, p1);
  if (__builtin_expect(__all(pmax <= lim), 1)) { alpha = 1.f; }
  else { const float mn = fmaxf(m_reg, ceilf(pmax)); alpha = __builtin_amdgcn_exp2f(m_reg - mn); m_reg = mn; sc = __builtin_amdgcn_exp2f(m_reg - P8_SHIFT); lim = fminf(m_reg + THR2, 126.f);
    for (int r = 0; r < 16; ++r) { p0[r] = fminf(p0[r], 126.f); p1[r] = fminf(p1[r], 126.f); } }
  for (int r = 0; r < 16; ++r) p0[r] = __builtin_amdgcn_exp2f(p0[r]);
}
__device__ __forceinline__ void finishSM(f32x16& p0, f32x16& p1, float sc, v8i& pf) {
  for (int r = 0; r < 16; ++r) p1[r] = __builtin_amdgcn_exp2f(p1[r]);
#pragma unroll
  for (int i = 0; i < 4; ++i) { pf[i] = (int)pk4s(p0[4 * i], p0[4 * i + 1], p0[4 * i + 2], p0[4 * i + 3], sc); pf[4 + i] = (int)pk4s(p1[4 * i], p1[4 * i + 1], p1[4 * i + 2], p1[4 * i + 3], sc); }
}
__device__ __forceinline__ v8i ld32(const char* base, int o0, int o1) { v8i f; f.lo = *reinterpret_cast<const v4i*>(base + o0); f.hi = *reinterpret_cast<const v4i*>(base + o1); return f; }
__device__ __forceinline__ void qkt_ld(v8i (&kf)[4], const char* Ks, int r32, int hi) {
  kf[0] = ld32(Ks, k_off(r32, hi), k_off(r32, 2 + hi)); kf[1] = ld32(Ks, k_off(32 + r32, hi), k_off(32 + r32, 2 + hi));
  kf[2] = ld32(Ks, k_off(r32, 4 + hi), k_off(r32, 6 + hi)); kf[3] = ld32(Ks, k_off(32 + r32, 4 + hi), k_off(32 + r32, 6 + hi));
}
__device__ __forceinline__ void qkt_mma(f32x16& p0, f32x16& p1, const v8i (&kf)[4], const v8i (&qf)[2]) {
  const f32x16 z = {};
  p0 = __builtin_amdgcn_mfma_scale_f32_32x32x64_f8f6f4(kf[0], qf[0], z, 0, 0, 0, 0x7f7f7f7f, 0, Q8_BLOCK_SCALE);
  p1 = __builtin_amdgcn_mfma_scale_f32_32x32x64_f8f6f4(kf[1], qf[0], z, 0, 0, 0, 0x7f7f7f7f, 0, Q8_BLOCK_SCALE);
  p0 = __builtin_amdgcn_mfma_scale_f32_32x32x64_f8f6f4(kf[2], qf[1], p0, 0, 0, 0, 0x7f7f7f7f, 0, Q8_BLOCK_SCALE);
  p1 = __builtin_amdgcn_mfma_scale_f32_32x32x64_f8f6f4(kf[3], qf[1], p1, 0, 0, 0, 0x7f7f7f7f, 0, Q8_BLOCK_SCALE);
}
__device__ __forceinline__ void pv_ld(v8i (&vf)[4], const char* Vs, int r32, int hi) {
  vf[0] = ld32(Vs, v_off(r32, 2 * hi), v_off(r32, 2 * hi + 1)); vf[1] = ld32(Vs, v_off(32 + r32, 2 * hi), v_off(32 + r32, 2 * hi + 1));
  vf[2] = ld32(Vs, v_off(64 + r32, 2 * hi), v_off(64 + r32, 2 * hi + 1)); vf[3] = ld32(Vs, v_off(96 + r32, 2 * hi), v_off(96 + r32, 2 * hi + 1));
}
__device__ __forceinline__ void pv_mma(f32x16* o, f32x16& ol, v8i pf, const v8i (&vf)[4], const v4i& ones) {
  const int us = 0x7f7f7f7f;
  asm volatile("s_nop 4\n\t"
               "v_mfma_scale_f32_32x32x64_f8f6f4 %0, %5, %6, %0, %11, %11 op_sel_hi:[0,0,0]\n\t"
               "v_mfma_scale_f32_32x32x64_f8f6f4 %1, %5, %7, %1, %11, %11 op_sel_hi:[0,0,0]\n\t"
               "v_mfma_scale_f32_32x32x64_f8f6f4 %2, %5, %8, %2, %11, %11 op_sel_hi:[0,0,0]\n\t"
               "v_mfma_scale_f32_32x32x64_f8f6f4 %3, %5, %9, %3, %11, %11 op_sel_hi:[0,0,0]\n\t"
               "v_mfma_scale_f32_32x32x64_f8f6f4 %4, %5, %10, %4, %11, %11 op_sel_hi:[0,0,0] blgp:4"
               : "+v"(o[0]), "+v"(o[1]), "+v"(o[2]), "+v"(o[3]), "+v"(ol)
               : "v"(pf), "v"(vf[0]), "v"(vf[1]), "v"(vf[2]), "v"(vf[3]), "v"(ones), "v"(us));
}
__device__ __forceinline__ void attn_unit(const bf16* __restrict__ Qb, const unsigned char* __restrict__ K8, const unsigned char* __restrict__ VT8, int vt_ld, bf16* __restrict__ Ob, int seq, int t0,
                                          const float* __restrict__ qgain, char* lds, LAS3 unsigned char* ldsa, const int tid_in) {
  int tid_ = tid_in; asm volatile("" : "+v"(tid_));
  const int tid = tid_, wid = __builtin_amdgcn_readfirstlane(tid >> 6), lane = tid & 63, r32 = lane & 31, hi = lane >> 5;
  char* K_lds = lds; char* V_lds = lds + RING * SHM_T;
  float* ws = (float*)(lds + 2 * RING * SHM_T) + wid * 64; float* li_l = ws; float* al_l = ws + 32;
  float m_reg = -1e30f; f32x16 o[4] = {}, ol = {}; v8i qf[2];
  v4i ones; { int e1 = 0x22222222; asm volatile("" : "+v"(e1)); ones[0] = e1; asm volatile("" : "+v"(e1)); ones[1] = e1; asm volatile("" : "+v"(e1)); ones[2] = e1; asm volatile("" : "+v"(e1)); ones[3] = e1; }
  {
    int tq = tid; asm volatile("" : "+v"(tq));
    const int hq = (tq >> 5) & 1;
    const bf16* Qw = Qb + (long)((tq >> 6) * QBLK + (tq & 31)) * LDQ + hq * 16;
    bf16x8 qraw[2][2][2];
#pragma unroll
    for (int ks = 0; ks < 2; ++ks)
#pragma unroll
      for (int g = 0; g < 2; ++g) { qraw[ks][g][0] = *reinterpret_cast<const bf16x8*>(Qw + ks * 64 + g * 32); qraw[ks][g][1] = *reinterpret_cast<const bf16x8*>(Qw + ks * 64 + g * 32 + 8); }
    float ss = 0.f;
#pragma unroll
    for (int ks = 0; ks < 2; ++ks)
#pragma unroll
      for (int g = 0; g < 2; ++g)
#pragma unroll
        for (int j = 0; j < 16; ++j) { const float x = bf2f(qraw[ks][g][j >> 3][j & 7]); ss += x * x; }
    { auto rr = __builtin_amdgcn_permlane32_swap(__float_as_uint(ss), __float_as_uint(ss), false, false); ss = __uint_as_float(rr[0]) + __uint_as_float(rr[1]); }
    const float rinv = Q8_SCALE / sqrtf(ss * (1.f / 128.f) + NORM_EPS);
    const int t = t0 + wid * QBLK + r32; const float prow = (float)(t / GRIDW), pcol = (float)(t % GRIDW);
#pragma unroll
    for (int ks = 0; ks < 2; ++ks) { const float pos = ks ? pcol : prow; float ylo[16], yhi[16];
#pragma unroll
      for (int j = 0; j < 16; ++j) { const int f = hq * 16 + j; const float ang = pos * att::rope_inv_freq(f); const float cs = __cosf(ang), sn = __sinf(ang);
        const float a = bf2f(qraw[ks][0][j >> 3][j & 7]) * rinv * qgain[ks * 64 + f], b = bf2f(qraw[ks][1][j >> 3][j & 7]) * rinv * qgain[ks * 64 + 32 + f];
        ylo[j] = a * cs - b * sn; yhi[j] = b * cs + a * sn; }
#pragma unroll
      for (int i = 0; i < 4; ++i) { qf[ks][i] = (int)pk4(ylo[4 * i], ylo[4 * i + 1], ylo[4 * i + 2], ylo[4 * i + 3]); qf[ks][4 + i] = (int)pk4(yhi[4 * i], yhi[4 * i + 1], yhi[4 * i + 2], yhi[4 * i + 3]); } }
  }
  const int skey = tid >> 3, sck = tid & 7, sd = tid >> 2, scv = tid & 3;
  const unsigned kgo = (unsigned)(skey * KV_W + ((sck ^ ((skey >> 1) & 7)) << 4)), vgo = (unsigned)(sd * vt_ld + ((scv ^ ((sd >> 2) & 3)) << 4));
  const int NT = seq / KVBLK;
  LAS3 unsigned char* Kd = ldsa + wid * 1024; LAS3 unsigned char* Vd = ldsa + RING * SHM_T + wid * 1024;
#define KDMA(t) do { const int t_ = (t) < NT ? (t) : NT - 1; __builtin_amdgcn_global_load_lds((const unsigned*)(K8 + (kgo + (unsigned)(t_ * KVBLK) * KV_W)), (LAS3 unsigned*)(Kd + ((t) & 7) * SHM_T), 16, 0, 0); } while (0)
#define VDMA(t) do { const int t_ = (t) < NT ? (t) : NT - 1; __builtin_amdgcn_global_load_lds((const unsigned*)(VT8 + (vgo + (unsigned)(t_ * KVBLK))), (LAS3 unsigned*)(Vd + ((t) & 7) * SHM_T), 16, 0, 0); } while (0)
#define RESC(a) do { if (__any((a) < 1.f)) { if (hi == 0) al_l[r32] = (a); asm volatile("s_waitcnt lgkmcnt(0)" ::: "memory"); \
    for (int r = 0; r < 16; ++r) { const float a_ = al_l[crow(r, hi)]; ol[r] *= a_; for (int d = 0; d < 4; ++d) o[d][r] *= a_; } } } while (0)
  f32x16 pA0, pA1, pB0, pB1; float alA, alB, sc, lim; v8i pf;
  v8i kf[4], vf[4];
#define WG_BAR(n) do { asm volatile("s_waitcnt vmcnt(" #n ")" ::: "memory"); __builtin_amdgcn_s_barrier(); asm volatile("" ::: "memory"); } while (0)
  KDMA(0); KDMA(1); KDMA(2); VDMA(0); VDMA(1); KDMA(3); KDMA(4); VDMA(2); VDMA(3); KDMA(5); KDMA(6); VDMA(4); VDMA(5);
  WG_BAR(8);
  qkt_ld(kf, K_lds, r32, hi); qkt_mma(pA0, pA1, kf, qf);
  qkt_ld(kf, K_lds + SHM_T, r32, hi); __builtin_amdgcn_sched_barrier(0);
  partialSM_first(pA0, pA1, m_reg, sc, lim, alA);
  WG_BAR(4);
  KDMA(7); KDMA(8); VDMA(6); VDMA(7);
  for (int j = 1; j + 1 < NT; j += 2) {
    qkt_mma(pB0, pB1, kf, qf);
    pv_ld(vf, V_lds + ((j - 1) & 7) * SHM_T, r32, hi); __builtin_amdgcn_sched_barrier(0);
    finishSM(pA0, pA1, sc, pf);
    pv_mma(o, ol, pf, vf, ones);
    qkt_ld(kf, K_lds + ((j + 1) & 7) * SHM_T, r32, hi); __builtin_amdgcn_sched_barrier(0);
    partialSM(pB0, pB1, m_reg, sc, lim, alB);
    RESC(alB);
    qkt_mma(pA0, pA1, kf, qf);
    pv_ld(vf, V_lds + (j & 7) * SHM_T, r32, hi); __builtin_amdgcn_sched_barrier(0);
    finishSM(pB0, pB1, sc, pf);
    pv_mma(o, ol, pf, vf, ones);
    qkt_ld(kf, K_lds + ((j + 2) & 7) * SHM_T, r32, hi); __builtin_amdgcn_sched_barrier(0);
    partialSM(pA0, pA1, m_reg, sc, lim, alA);
    RESC(alA);
    WG_BAR(4);
    KDMA(j + 8); KDMA(j + 9); VDMA(j + 7); VDMA(j + 8);
  }
  qkt_mma(pB0, pB1, kf, qf);
  pv_ld(vf, V_lds + ((NT - 2) & 7) * SHM_T, r32, hi); __builtin_amdgcn_sched_barrier(0);
  finishSM(pA0, pA1, sc, pf);
  pv_mma(o, ol, pf, vf, ones);
  pv_ld(vf, V_lds + ((NT - 1) & 7) * SHM_T, r32, hi); __builtin_amdgcn_sched_barrier(0);
  partialSM(pB0, pB1, m_reg, sc, lim, alB);
  RESC(alB);
  finishSM(pB0, pB1, sc, pf);
  pv_mma(o, ol, pf, vf, ones);
  asm volatile("s_nop 15\n\ts_nop 15" : "+v"(o[0]), "+v"(o[1]), "+v"(o[2]), "+v"(o[3]), "+v"(ol) :: "memory");
  float rli[16];
#pragma unroll
  for (int r = 0; r < 16; ++r) rli[r] = __builtin_amdgcn_rcpf(ol[r] * V8_SCALE);
  int te = tid; asm volatile("" : "+v"(te));
  const int r32e = te & 31, hie = (te >> 5) & 1, wide = te >> 6;
  bf16* Ow = Ob + (long)(wide * QBLK) * LDO;
#pragma unroll
  for (int r = 0; r < 16; ++r) { int orow = crow(r, hie);
    for (int d0 = 0; d0 < 4; ++d0) { const float v = o[d0][r] * rli[r]; unsigned u = __float_as_uint(v); u = (u + 0x7fffu + ((u >> 16) & 1u)) >> 16;
      Ow[(long)orow * LDO + d0 * 32 + r32e] = (bf16)u; } }
  asm volatile("s_waitcnt vmcnt(0)" ::: "memory");
  __syncthreads();
#undef KDMA
#undef VDMA
#undef WG_BAR
#undef RESC
}
}

constexpr int NWAVES = 8, NTHREADS = NWAVES * 64;
constexpr int N_PHASES = 14;
constexpr int N_LAUNCHES = MK_N_LAUNCHES;
static_assert(N_LAUNCHES == 1 || N_LAUNCHES == N_PHASES, "MK_N_LAUNCHES is 1 or 14");

constexpr size_t MiB = 1u << 20;
constexpr size_t WS_CTL = 0, CTL_ZERO_BYTES = 1 * MiB;
constexpr size_t WS_MODL = 1 * MiB;
constexpr size_t WS_MODC = WS_MODL + 12288 * 4;
constexpr size_t WS_RBIAS = WS_MODC + 4096 * 4;
constexpr size_t WS_TILE_E = WS_RBIAS + 256;
constexpr size_t WS_TILE_ROW = WS_TILE_E + 4096;
constexpr size_t WS_WRHI = 2 * MiB;
constexpr size_t WS_WRLO = WS_WRHI + 64 * 2048 * 2;
constexpr size_t WS_GT = 3 * MiB;
constexpr size_t WS_TOPI = 4 * MiB;
constexpr size_t WS_TOPW = WS_TOPI + (size_t)SEQ * 8 * 4;
constexpr size_t WS_RANK = WS_TOPW + (size_t)SEQ * 8 * 4;
constexpr size_t WS_SLOT_TOK = 6 * MiB;
constexpr size_t WS_SLOT_OF = WS_SLOT_TOK + (size_t)MAX_SLOTS * 4;
constexpr size_t WS_SLOT_W = WS_SLOT_OF + (size_t)MAX_SLOTS * 4;
constexpr size_t WS_AGGP = 8 * MiB;
constexpr size_t AGG_BYTES = (size_t)2 * NCH * 1024 * 4;
constexpr size_t WS_AGGH = WS_AGGP + AGG_BYTES;
constexpr size_t WS_CIN = WS_AGGH + AGG_BYTES;
static_assert(WS_SLOT_W + (size_t)MAX_SLOTS * 4 <= WS_AGGP && WS_CIN + AGG_BYTES <= 25 * MiB && WS_RANK + (size_t)SEQ * 32 <= WS_SLOT_TOK, "ws misc map");
constexpr size_t WS_W2T = 25 * MiB;
constexpr size_t WS_HH = WS_W2T + (size_t)NEXP1 * 2048 * 512 * 2;
constexpr size_t WS_ARENA = WS_HH + (size_t)MAX_SLOTS * EFF * 2;
constexpr size_t WS_W13T = WS_ARENA;
constexpr size_t WS_V = WS_W13T + (size_t)NEXP1 * 1024 * 2048 * 2;
constexpr size_t WS_U = WS_V + 65 * MiB;
constexpr size_t WS_P = WS_U + (size_t)MTOT * DM * 2;
constexpr size_t WS_CAT = WS_P + 114 * MiB;
constexpr size_t WS_WINT = WS_CAT + (size_t)SEQ * DM * 2;
constexpr size_t WS_WOUTT = WS_WINT + (size_t)PROJ_W * DM * 2;
constexpr size_t WS_KN = WS_WOUTT + (size_t)DM * DM * 2;
constexpr size_t WS_VN = WS_KN + (size_t)MTOT * KV_W * 2;
constexpr size_t WS_END = WS_ARENA + (size_t)MAX_SLOTS * DM * 2;
constexpr size_t WS_Y = WS_ARENA;
constexpr size_t WS_MIX = WS_U;
static_assert(WS_VN + (size_t)MTOT * KV_W * 2 <= WS_END && (size_t)MTOT * PROJ_W * 2 <= 114 * MiB && (size_t)(SEQ + 1) * DM * 2 <= 65 * MiB, "ws arena map");
constexpr int CW_TMO = 0, CW_CODE = 1, CW_CNT = 64, CW_NT = 192, CW_BAR = 4096;

constexpr int RING_BYTES = 131072, PHASE_LDS = 143360, LDSCTL_OFF = PHASE_LDS, MISC_OFF = LDSCTL_OFF + 320, LDS_BYTES = 147456;

#define GAS __attribute__((address_space(1)))
#define LAS __attribute__((address_space(3)))
typedef unsigned short bf16;
typedef unsigned v4u __attribute__((ext_vector_type(4)));
typedef unsigned v2u __attribute__((ext_vector_type(2)));
typedef float f32x4 __attribute__((ext_vector_type(4)));
typedef short bf16x8 __attribute__((ext_vector_type(8)));
typedef float f32x16 __attribute__((ext_vector_type(16)));
typedef GAS unsigned gu32;
#define RLX_AGENT __ATOMIC_RELAXED, __HIP_MEMORY_SCOPE_AGENT
#define LDS_WAIT() asm volatile("s_waitcnt lgkmcnt(0)" ::: "memory")
#define VM_WAIT() asm volatile("s_waitcnt vmcnt(0)" ::: "memory")
__device__ __forceinline__ unsigned f2bf(float f) { unsigned u = __builtin_bit_cast(unsigned, f); return (u + 0x7fffu + ((u >> 16) & 1u)) >> 16; }
__device__ __forceinline__ unsigned pk2(float lo, float hi) { return f2bf(lo) | (f2bf(hi) << 16); }
__device__ __forceinline__ float bf_lo(unsigned w) { return __uint_as_float(w << 16); }
__device__ __forceinline__ float bf_hi(unsigned w) { return __uint_as_float(w & 0xffff0000u); }
__device__ __forceinline__ float wave_sum(float v) {
#pragma unroll
    for (int o = 1; o < 64; o <<= 1) v += __shfl_xor(v, o);
    return v;
}

#define XB_TMO      128
#define XB_XCNT(j)  (256  + 64 * (j))
#define XB_XSUB(j)  (1280 + 64 * (j))
#define XB_XGEN(j)  (2304 + 64 * (j))
#define XB_TOP      3328
#define XB_TOPGEN   3392
#define XCD_BAR_WORDS 3456
#define XB_SPIN_CAP (1u << 18)
__device__ __forceinline__ unsigned xb_ld(unsigned* p)              { return __hip_atomic_load(p, __ATOMIC_RELAXED, __HIP_MEMORY_SCOPE_AGENT); }
__device__ __forceinline__ unsigned xb_add(unsigned* p, unsigned v) { return __hip_atomic_fetch_add(p, v, __ATOMIC_RELAXED, __HIP_MEMORY_SCOPE_AGENT); }
__device__ __forceinline__ unsigned xb_xcc_id() { return (unsigned)__builtin_amdgcn_s_getreg((3 << 11) | 20) & 0xFu; }
#define XB_SPIN(cond, bar) do { unsigned _sp = 0; while (cond) { __builtin_amdgcn_s_sleep(1); \
    if ((++_sp & 255u) == 0u) { if (xb_ld(&(bar)[XB_TMO])) break; if (_sp > XB_SPIN_CAP) { atomicAdd(&(bar)[XB_TMO], 1u); break; } } } } while (0)
struct XcdBarrier { unsigned* bar; unsigned x; volatile LAS unsigned* st; int w0; };
__device__ __forceinline__ bool xb_is_thread0(int w0) { return w0 == 0 && __builtin_amdgcn_mbcnt_hi(~0u, __builtin_amdgcn_mbcnt_lo(~0u, 0u)) == 0u; }
__device__ __forceinline__ XcdBarrier xcd_barrier_post(unsigned* bar, volatile LAS unsigned* st, int w0) {
    XcdBarrier b; b.bar = bar; b.x = xb_xcc_id(); b.st = st; b.w0 = w0;
    if (xb_is_thread0(w0)) (void)xb_add(&bar[XB_XCNT(b.x)], 1u);
    return b;
}
__device__ __forceinline__ void xcd_barrier_complete(unsigned* bar, unsigned x, unsigned& nloc, unsigned& nx) {
    const unsigned G = gridDim.x * gridDim.y * gridDim.z;
    unsigned sum, cnt, mine, sp = 0u;
    for (;;) {
        sum = 0u; cnt = 0u; mine = 0u;
#pragma unroll
        for (unsigned j = 0; j < 16; ++j) { const unsigned c = xb_ld(&bar[XB_XCNT(j)]); sum += c; cnt += (c > 0u) ? 1u : 0u; mine = (j == x) ? c : mine; }
        if (sum == G) break;
        __builtin_amdgcn_s_sleep(1);
        if ((++sp & 255u) == 0u) { if (xb_ld(&bar[XB_TMO])) break; if (sp > XB_SPIN_CAP) { atomicAdd(&bar[XB_TMO], 1u); break; } }
    }
    nloc = mine > 0u ? mine : 1u; nx = cnt > 0u ? cnt : 1u;
}
__device__ __forceinline__ void xcd_barrier(const XcdBarrier& b) {
    asm volatile("s_waitcnt vmcnt(0)" ::: "memory");
    __syncthreads();
    if (xb_is_thread0(b.w0)) {
        unsigned* bar = b.bar;
        __builtin_amdgcn_s_waitcnt(0);
        unsigned nloc = b.st[0], nx = b.st[1];
        if (nloc == 0u) { xcd_barrier_complete(bar, b.x, nloc, nx); b.st[0] = nloc; b.st[1] = nx; }
        const unsigned old = xb_add(&bar[XB_XSUB(b.x)], 1u);
        const unsigned gen = old / nloc;
        if (old + 1u == (gen + 1u) * nloc) {
            __builtin_amdgcn_fence(__ATOMIC_RELEASE, "agent");
            asm volatile("s_waitcnt vmcnt(0)" ::: "memory");
            const unsigned og = xb_add(&bar[XB_TOP], 1u);
            const unsigned tg = og / nx;
            if (og + 1u == (tg + 1u) * nx) xb_add(&bar[XB_TOPGEN], 1u);
            else XB_SPIN(xb_ld(&bar[XB_TOPGEN]) == tg, bar);
            __builtin_amdgcn_fence(__ATOMIC_ACQUIRE, "agent");
            xb_add(&bar[XB_XGEN(b.x)], 1u);
            asm volatile("s_waitcnt vmcnt(0)" ::: "memory");
        } else {
            XB_SPIN(xb_ld(&bar[XB_XGEN(b.x)]) == gen, bar);
            __builtin_amdgcn_fence(__ATOMIC_ACQUIRE, "agent");
            asm volatile("s_waitcnt vmcnt(0)" ::: "memory");
        }
    }
    __syncthreads();
}

struct Frame {
    LAS unsigned char* lds; char* ldsg;
    volatile LAS unsigned* MISC;
    gu32* ctl;
    int tid, lane, wave, G, bid;
    const float* in[29]; float* out; unsigned char* ws;
};
__device__ __forceinline__ int ldi_agent(const void* p) { return __hip_atomic_load((const int*)p, __ATOMIC_RELAXED, __HIP_MEMORY_SCOPE_AGENT); }

__device__ __forceinline__ void tr_item(const float* W, int ldw, int k0, int n0, bf16* dst, int ldt, LAS float* scr, int lane) {
    const int kr = lane >> 4, nc = (lane & 15) * 4;
    f32x4 v[16];
#pragma unroll
    for (int i = 0; i < 16; ++i) v[i] = __builtin_nontemporal_load((const f32x4*)(W + (size_t)(k0 + 4 * i + kr) * ldw + n0 + nc));
#pragma unroll
    for (int i = 0; i < 16; ++i) { LAS float* p = scr + (4 * i + kr) * 65 + nc; p[0] = v[i].x; p[1] = v[i].y; p[2] = v[i].z; p[3] = v[i].w; }
    LDS_WAIT(); asm volatile("" ::: "memory");
    const int c = lane & 7;
#pragma unroll
    for (int j = 0; j < 8; ++j) { const int n = (lane >> 3) + 8 * j; const LAS float* s = scr + (8 * c) * 65 + n;
        v4u o; o.x = pk2(s[0 * 65], s[1 * 65]); o.y = pk2(s[2 * 65], s[3 * 65]); o.z = pk2(s[4 * 65], s[5 * 65]); o.w = pk2(s[6 * 65], s[7 * 65]);
        *(GAS v4u*)(dst + (size_t)n * ldt + k0 + 8 * c) = o; }
    LDS_WAIT(); asm volatile("" ::: "memory");
}
__device__ __forceinline__ void tr_item8(const float* W, int ldw, int k0, int n0, unsigned char* dst, int ldt, float wscale, LAS float* scr, int lane) {
    const int kr = lane >> 4, nc = (lane & 15) * 4;
    f32x4 v[16];
#pragma unroll
    for (int i = 0; i < 16; ++i) v[i] = __builtin_nontemporal_load((const f32x4*)(W + (size_t)(k0 + 4 * i + kr) * ldw + n0 + nc));
#pragma unroll
    for (int i = 0; i < 16; ++i) { LAS float* p = scr + (4 * i + kr) * 65 + nc; p[0] = v[i].x; p[1] = v[i].y; p[2] = v[i].z; p[3] = v[i].w; }
    LDS_WAIT(); asm volatile("" ::: "memory");
    const int c = lane & 3;
#pragma unroll
    for (int j = 0; j < 4; ++j) { const int n = (lane >> 2) + 16 * j; const LAS float* s = scr + (16 * c) * 65 + n;
        v4u o;
        o.x = pg8::pk4_fp8(s[0 * 65] * wscale, s[1 * 65] * wscale, s[2 * 65] * wscale, s[3 * 65] * wscale); o.y = pg8::pk4_fp8(s[4 * 65] * wscale, s[5 * 65] * wscale, s[6 * 65] * wscale, s[7 * 65] * wscale);
        o.z = pg8::pk4_fp8(s[8 * 65] * wscale, s[9 * 65] * wscale, s[10 * 65] * wscale, s[11 * 65] * wscale); o.w = pg8::pk4_fp8(s[12 * 65] * wscale, s[13 * 65] * wscale, s[14 * 65] * wscale, s[15 * 65] * wscale);
        *(GAS v4u*)(dst + (size_t)n * ldt + k0 + 16 * c) = o; }
    LDS_WAIT(); asm volatile("" ::: "memory");
}
__device__ __forceinline__ float silu_acc(float x) { return x / (1.f + expf(-x)); }
__device__ __forceinline__ void p0_prologue(Frame& F) {
    {
        LAS float* sL = (LAS float*)(F.lds);
        LAS float* sC = sL + 2048;
        LAS float* red = sC + 2048;
        const float* c = F.in[1]; const float* cc = F.in[3]; const float* wm = F.in[4]; const float* bm = F.in[5];
        float* modl = (float*)(F.ws + WS_MODL); float* modc = (float*)(F.ws + WS_MODC);
        bool filled = false;
        for (int item = F.bid; item < 192; item += F.G) {
            if (!filled) { for (int k = F.tid; k < 2048; k += NTHREADS) { sL[k] = silu_acc(c[k]); sC[k] = silu_acc(cc[k]); } filled = true; __syncthreads(); }
            const int cg = F.tid & 15, ks = F.tid >> 4, col = item * 64 + cg * 4; const bool doc = item < 64;
            f32x4 aL = {0.f, 0.f, 0.f, 0.f}, aC = {0.f, 0.f, 0.f, 0.f};
#pragma unroll 8
            for (int i = 0; i < 64; ++i) { const int k = ks + 32 * i; const f32x4 w = *(const f32x4*)(wm + (size_t)k * 12288 + col); aL += w * sL[k]; aC += w * sC[k]; }
            *(LAS f32x4*)(red + ks * 64 + cg * 4) = aL; *(LAS f32x4*)(red + 2048 + ks * 64 + cg * 4) = aC;
            __syncthreads();
            if (F.tid < 128) { const int which = F.tid >> 6, j = F.tid & 63; float s = 0.f;
#pragma unroll
                for (int q = 0; q < 32; ++q) s += red[which * 2048 + q * 64 + j];
                s += bm[item * 64 + j];
                if (which == 0) modl[item * 64 + j] = s; else if (doc) modc[item * 64 + j] = s; }
            __syncthreads();
        }
        __syncthreads();
    }
    LAS float* scr = (LAS float*)(F.lds + F.wave * 16640);
    const int gw = F.bid * NWAVES + F.wave, NGW = F.G * NWAVES;
    constexpr int I_IN = 32 * 56, I_OUT = 32 * 32, I_E13 = NEXP1 * 2 * 256, I_E2 = NEXP1 * 256, I_G = 32 * 4;
    constexpr int NITEMS = I_IN + I_OUT + I_E13 + I_E2 + I_G;
    for (int it = gw; it < NITEMS; it += NGW) {
        int r = it;
        if (r < I_IN) { const int kb = r / 56, nb = r % 56; tr_item(F.in[6], PROJ_W, 64 * kb, 64 * nb, (bf16*)(F.ws + WS_WINT) + (size_t)(64 * nb) * DM, DM, scr, F.lane); continue; } r -= I_IN;
        if (r < I_OUT) { const int kb = r / 32, nb = r % 32; tr_item(F.in[16], DM, 64 * kb, 64 * nb, (bf16*)(F.ws + WS_WOUTT) + (size_t)(64 * nb) * DM, DM, scr, F.lane); continue; } r -= I_OUT;
        if (r < I_E13) { const int e = r / 512, q = r % 512, mat = q / 256, kb = (q % 256) / 8, nb = q % 8, n0 = 64 * nb;
            const float* W = (e < NEXP) ? (mat ? F.in[22] : F.in[21]) + (size_t)e * DM * EFF : (mat ? F.in[25] : F.in[24]);
            unsigned char* dst = (unsigned char*)(F.ws + WS_W13T) + ((size_t)e * 1024 + (n0 >> 7) * 256 + mat * 128 + (n0 & 127)) * DM;
            tr_item8(W, EFF, 64 * kb, n0, dst, DM, W_SCALE, scr, F.lane); continue; } r -= I_E13;
        if (r < I_E2) { const int e = r / 256, q = r % 256, kb = q / 32, nb = q % 32;
            const float* W = (e < NEXP) ? F.in[23] + (size_t)e * EFF * DM : F.in[26];
            tr_item8(W, DM, 64 * kb, 64 * nb, (unsigned char*)(F.ws + WS_W2T) + ((size_t)e * DM + 64 * nb) * EFF, EFF, W_SCALE, scr, F.lane); continue; } r -= I_E2;
        { const int mi = r / 4, q = r % 4, kb = q / 2, nb = q % 2, d = mi >> 4, gate = (mi >> 3) & 1, h = mi & 7;
            const float* W = (gate ? F.in[13] : F.in[11]) + (size_t)(d * 8 + h) * 16384;
            tr_item(W, 128, 64 * kb, 64 * nb, (bf16*)(F.ws + WS_GT) + (size_t)mi * 16384 + (size_t)(64 * nb) * 128, 128, scr, F.lane); }
    }
}

__device__ __forceinline__ void p1_modulate(Frame& F) {
    const int gw = F.bid * NWAVES + F.wave, NGW = F.G * NWAVES;
    const float* modl = (const float*)(F.ws + WS_MODL); const float* modc = (const float*)(F.ws + WS_MODC);
    bf16* U = (bf16*)(F.ws + WS_U);
    for (int m = gw; m < MTOT; m += NGW) {
        const float* src = (m < CTXL) ? F.in[2] + (size_t)m * DM : F.in[0] + (size_t)(m - CTXL) * DM;
        const float* md = (m < CTXL) ? modc : modl;
        GAS unsigned long long* o8 = (GAS unsigned long long*)(U + (size_t)m * DM) + F.lane;
#pragma unroll
        for (int j = 0; j < 8; ++j) { const int col = 4 * F.lane + 256 * j; const f32x4 v = *(const f32x4*)(src + col), sh = *(const f32x4*)(md + col), sc = *(const f32x4*)(md + 2048 + col);
            const f32x4 u = v * (sc + 1.0f) + sh;
            o8[64 * j] = (unsigned long long)pk2(u.x, u.y) | ((unsigned long long)pk2(u.z, u.w) << 32); }
    }
    if (F.bid < NEXP) { const int e = F.bid; const float* wr = F.in[19]; bf16* hiP = (bf16*)(F.ws + WS_WRHI) + (size_t)e * DM; bf16* loP = (bf16*)(F.ws + WS_WRLO) + (size_t)e * DM; float bs = 0.f;
        float w0v[4], scv[4], shv[4];
#pragma unroll
        for (int i = 0; i < 4; ++i) { const int k = F.wave * 256 + F.lane + 64 * i; w0v[i] = wr[(size_t)k * NEXP + e]; scv[i] = modl[8192 + k]; shv[i] = modl[6144 + k]; }
#pragma unroll
        for (int i = 0; i < 4; ++i) { const int k = F.wave * 256 + F.lane + 64 * i; const float w = w0v[i] * (1.0f + scv[i]);
            const unsigned h = f2bf(w); const float hf = __uint_as_float(h << 16); hiP[k] = (bf16)h; loP[k] = (bf16)f2bf(w - hf); bs += shv[i] * w0v[i]; }
        bs = wave_sum(bs); float* red = (float*)F.ldsg;
        if (F.lane == 0) red[F.wave] = bs;
        __syncthreads();
        if (F.tid == 0) { float t = 0.f; for (int w = 0; w < NWAVES; ++w) t += red[w]; ((float*)(F.ws + WS_RBIAS))[e] = t; }
        __syncthreads(); }
    if (gw == NGW - 1) { GAS v4u* z = (GAS v4u*)((unsigned char*)(F.ws + WS_V) + (size_t)SEQ * DM);
        for (int i = F.lane; i < DM / 16; i += 64) z[i] = (v4u){0u, 0u, 0u, 0u}; }
}

__device__ __forceinline__ void p3_knorm(Frame& F) {
    const int gw = F.bid * NWAVES + F.wave, NGW = F.G * NWAVES;
    const bf16* P = (const bf16*)(F.ws + WS_P); bf16* KN = (bf16*)(F.ws + WS_KN); bf16* VN = (bf16*)(F.ws + WS_VN); const float* kg = F.in[8];
    const float g0 = kg[F.lane], g1 = kg[64 + F.lane]; const int f = F.lane & 31; const float ifr = att::rope_inv_freq(f);
    for (int it = gw; it < (MTOT / 4) * NKV; it += NGW) {
        const int m0 = (it >> 1) * 4, kvh = it & 1;
        float k0[4], k1[4]; unsigned short v0[4], v1[4];
#pragma unroll
        for (int i = 0; i < 4; ++i) { const bf16* p = P + (size_t)(m0 + i) * PROJ_W + COL_K + kvh * HD; const bf16* pv = P + (size_t)(m0 + i) * PROJ_W + COL_V + kvh * HD;
            k0[i] = __uint_as_float(((unsigned)p[F.lane]) << 16); k1[i] = __uint_as_float(((unsigned)p[64 + F.lane]) << 16); v0[i] = pv[F.lane]; v1[i] = pv[64 + F.lane]; }
#pragma unroll
        for (int i = 0; i < 4; ++i) { const int m = m0 + i;
            const float ss = wave_sum(k0[i] * k0[i] + k1[i] * k1[i]); const float rinv = 1.0f / sqrtf(ss * (1.f / 128.f) + NORM_EPS);
            float y0 = k0[i] * rinv * g0, y1 = k1[i] * rinv * g1;
            if (m >= CTXL) { const int t = m - CTXL; const float a0 = (float)(t / GRIDW) * ifr, a1 = (float)(t % GRIDW) * ifr;
                const float c0 = __cosf(a0), s0 = __sinf(a0), c1 = __cosf(a1), s1 = __sinf(a1);
                const float q0 = __shfl_xor(y0, 32), q1 = __shfl_xor(y1, 32);
                if (F.lane < 32) { y0 = y0 * c0 - q0 * s0; y1 = y1 * c1 - q1 * s1; } else { y0 = y0 * c0 + q0 * s0; y1 = y1 * c1 + q1 * s1; } }
            bf16* o = KN + (size_t)m * KV_W + kvh * HD; bf16* ov = VN + (size_t)m * KV_W + kvh * HD;
            o[F.lane] = (bf16)f2bf(y0); o[64 + F.lane] = (bf16)f2bf(y1); ov[F.lane] = v0[i]; ov[64 + F.lane] = v1[i]; }
    }
}

__device__ __forceinline__ void p3_knorm8(Frame& F) {
    const bf16* P = (const bf16*)(F.ws + WS_P); unsigned char* KN8 = (unsigned char*)(F.ws + WS_KN); unsigned char* VT8 = (unsigned char*)(F.ws + WS_VN); const float* kg = F.in[8];
    unsigned char* vt_l = (unsigned char*)F.ldsg;
    for (int it = F.bid; it < MTOT / 64; it += F.G) {
        const int m0 = it * 64;
        { const int row = F.tid >> 3, kvh = (F.tid >> 2) & 1, g = F.tid & 3, m = m0 + row;
          const bf16* kp = P + (size_t)m * PROJ_W + COL_K + kvh * HD + g * 8;
          v4u raw[2][2];
#pragma unroll
          for (int b = 0; b < 2; ++b) { raw[b][0] = *(const v4u*)(kp + b * 64); raw[b][1] = *(const v4u*)(kp + b * 64 + 32); }
          float x[2][2][8]; float ss = 0.f;
#pragma unroll
          for (int b = 0; b < 2; ++b)
#pragma unroll
            for (int q = 0; q < 2; ++q) { const v4u w = raw[b][q]; x[b][q][0] = bf_lo(w.x); x[b][q][1] = bf_hi(w.x); x[b][q][2] = bf_lo(w.y); x[b][q][3] = bf_hi(w.y); x[b][q][4] = bf_lo(w.z); x[b][q][5] = bf_hi(w.z); x[b][q][6] = bf_lo(w.w); x[b][q][7] = bf_hi(w.w);
#pragma unroll
              for (int i = 0; i < 8; ++i) ss += x[b][q][i] * x[b][q][i]; }
          ss += __shfl_xor(ss, 1); ss += __shfl_xor(ss, 2);
          const float rinv = att8::K8_SCALE / sqrtf(ss * (1.f / 128.f) + NORM_EPS);
          unsigned char* ko = KN8 + (size_t)m * KV_W + kvh * HD + g * 8;
#pragma unroll
          for (int b = 0; b < 2; ++b) { float lo[8], hi_[8]; const float pos = (m < CTXL) ? 0.f : (b ? (float)((m - CTXL) % GRIDW) : (float)((m - CTXL) / GRIDW));
#pragma unroll
            for (int i = 0; i < 8; ++i) { const int f = g * 8 + i; float cs = 1.f, sn = 0.f; if (m >= CTXL) { const float ang = pos * att::rope_inv_freq(f); cs = __cosf(ang); sn = __sinf(ang); }
                const float a = x[b][0][i] * rinv * kg[b * 64 + f], c = x[b][1][i] * rinv * kg[b * 64 + 32 + f]; lo[i] = a * cs - c * sn; hi_[i] = c * cs + a * sn; }
            *(v2u*)(ko + b * 64) = (v2u){att8::pk4(lo[0], lo[1], lo[2], lo[3]), att8::pk4(lo[4], lo[5], lo[6], lo[7])};
            *(v2u*)(ko + b * 64 + 32) = (v2u){att8::pk4(hi_[0], hi_[1], hi_[2], hi_[3]), att8::pk4(hi_[4], hi_[5], hi_[6], hi_[7])}; } }
        { const int row = F.tid >> 3, c = F.tid & 7, kvh = c >> 2, d0 = (c & 3) * 32; const bf16* vp = P + (size_t)(m0 + row) * PROJ_W + COL_V + kvh * HD + d0;
          const int kpos = ((row >> 2) & 1) * 32 + (row >> 5) * 16 + ((row >> 3) & 3) * 4 + (row & 3);
#pragma unroll
          for (int q = 0; q < 4; ++q) { const v4u w = *(const v4u*)(vp + q * 8); const float xv[8] = {bf_lo(w.x), bf_hi(w.x), bf_lo(w.y), bf_hi(w.y), bf_lo(w.z), bf_hi(w.z), bf_lo(w.w), bf_hi(w.w)};
#pragma unroll
            for (int i = 0; i < 8; i += 4) { const unsigned pk = att8::pk4(xv[i] * att8::V8_SCALE, xv[i + 1] * att8::V8_SCALE, xv[i + 2] * att8::V8_SCALE, xv[i + 3] * att8::V8_SCALE);
#pragma unroll
              for (int e = 0; e < 4; ++e) vt_l[(kvh * 128 + d0 + q * 8 + i + e) * 80 + kpos] = (unsigned char)(pk >> (8 * e)); } } }
        __syncthreads();
        {
          const int rowi = F.tid >> 1, half = F.tid & 1; const unsigned char* src = vt_l + rowi * 80 + half * 32;
          const v4u a = *(const v4u*)src, b = *(const v4u*)(src + 16);
          unsigned char* dst = VT8 + (size_t)rowi * MTOT + m0 + half * 32; *(v4u*)dst = a; *(v4u*)(dst + 16) = b; }
        __syncthreads();
    }
}

constexpr int RG_XCB = 0, RG_XCF = 16384, RG_XCH = 49152, RG_CWL = 81920;
__device__ __forceinline__ float log_sigmoid_f(float x) { return fminf(x, 0.f) - log1pf(expf(-fabsf(x))); }
__device__ __forceinline__ float gelu_tanh_f(float x) { const float u = 0.7978845608028654f * (x + 0.044715f * x * x * x); const float e = __expf(2.f * u); const float th = 1.f - 2.f * __builtin_amdgcn_rcpf(e + 1.f); return 0.5f * x * (1.f + th); }
__device__ __forceinline__ float sigmoid_fast(float x) { return __builtin_amdgcn_rcpf(1.f + __expf(-x)); }
__device__ __forceinline__ float one_minus_exp(float x) {
    const float ser = -x * (1.f + x * (0.5f + x * (0.16666667f + x * (0.041666668f + x * 0.0083333338f))));
    return (x > -0.25f) ? ser : (1.f - __expf(x));
}
template <int DIR, int PASS>
__device__ __forceinline__ void rg_scan(const float (&av)[16], float (&bv)[16], float carry, int hi, float& run_out, float& prod_out) {
    float gA[4], gB[4];
#pragma unroll
    for (int g = 0; g < 4; ++g) { float A_ = 1.f, B_ = 0.f;
#pragma unroll
        for (int jj = 0; jj < 4; ++jj) { const int r = 4 * g + (DIR ? 3 - jj : jj); B_ = av[r] * B_ + bv[r]; A_ *= av[r]; }
        gA[g] = A_; gB[g] = B_; }
    float pA[4], pB[4];
#pragma unroll
    for (int g = 0; g < 4; ++g) { pA[g] = __shfl_xor(gA[g], 32); pB[g] = __shfl_xor(gB[g], 32); }
    float cin[4] = {0.f, 0.f, 0.f, 0.f}; float run = carry, prod = 1.f;
#pragma unroll
    for (int s = 0; s < 8; ++s) { constexpr int dummy = 0; (void)dummy; const int G = DIR ? 7 - s : s, g = G >> 1, gh = G & 1;
        const bool mine = (gh == hi); const float A_ = mine ? gA[g] : pA[g], B_ = mine ? gB[g] : pB[g];
        cin[g] = mine ? run : cin[g];
        run = A_ * run + B_; prod *= A_; }
    if (PASS == 2) {
#pragma unroll
        for (int g = 0; g < 4; ++g) { float hs = cin[g];
#pragma unroll
            for (int jj = 0; jj < 4; ++jj) { const int r = 4 * g + (DIR ? 3 - jj : jj); hs = av[r] * hs + bv[r]; bv[r] = hs; } } }
    run_out = run; prod_out = prod;
}
template <int PASS>
__device__ __forceinline__ void rg_phase(Frame& F) {
    const bf16* P = (const bf16*)(F.ws + WS_P);
    char* L = F.ldsg;
    const int h = F.bid & 7, cs0 = F.bid >> 3, cstride = F.G >> 3;
    const int d = F.wave >> 2, q = F.wave & 3, r32 = F.lane & 31, hi = F.lane >> 5;
    constexpr int nch = (PASS == 1) ? NCH : NCH_LAT, cbase = (PASS == 1) ? 0 : NCH_CTX;
    bf16x8 BA[8], BX[8];
    { const bf16* GTa = (const bf16*)(F.ws + WS_GT) + (size_t)((d * 2 + 0) * 8 + h) * 16384 + (size_t)(q * 32 + r32) * 128 + hi * 8;
      const bf16* GTx = (const bf16*)(F.ws + WS_GT) + (size_t)((d * 2 + 1) * 8 + h) * 16384 + (size_t)(q * 32 + r32) * 128 + hi * 8;
#pragma unroll
      for (int ks = 0; ks < 8; ++ks) { BA[ks] = *(const bf16x8*)(GTa + ks * 16); BX[ks] = *(const bf16x8*)(GTx + ks * 16); } }
    const int ch = q * 32 + r32, gch = h * HD + ch;
    const float biasA = F.in[12][d * RG_W + gch], biasX = F.in[14][d * RG_W + gch], Lc = 8.0f * log_sigmoid_f(F.in[15][d * RG_W + gch]);
    const int tt = F.tid >> 4, cg = F.tid & 15, ch0 = h * HD + cg * 8;
    float* CWL = (float*)(L + RG_CWL);
    for (int i = F.tid; i < 5 * 128; i += NTHREADS) { const int j = i >> 7, c = i & 127; CWL[i] = (j < 4) ? F.in[9][j * RG_W + h * HD + c] : F.in[10][h * HD + c]; }
    __syncthreads();
    v4u raw[4];
#define RG_LOADRAW(CI) do { const int cidx_ = cbase + (CI); const bool ic_ = cidx_ < NCH_CTX; const int t_ = (ic_ ? cidx_ * RG_CH : (cidx_ - NCH_CTX) * RG_CH) + tt, sl_ = ic_ ? CTXL : SEQ, rb_ = ic_ ? 0 : CTXL; \
        _Pragma("unroll") for (int j = 0; j < 4; ++j) { const int ts = t_ + j - 2; raw[j] = (v4u){0u, 0u, 0u, 0u}; if (ts >= 0 && ts < sl_) raw[j] = *(const v4u*)(P + (size_t)(rb_ + ts) * PROJ_W + COL_XR + ch0); } } while (0)
    int ci = cs0; int buf = 0;
    if (ci < nch) RG_LOADRAW(ci);
    for (; ci < nch; ci += cstride, buf ^= 1) {
        const int cidx = cbase + ci; const bool isctx = cidx < NCH_CTX; const int t0 = isctx ? cidx * RG_CH : (cidx - NCH_CTX) * RG_CH;
        { float xc[8];
          { const f32x4 b0 = *(const f32x4*)(CWL + 4 * 128 + cg * 8), b1 = *(const f32x4*)(CWL + 4 * 128 + cg * 8 + 4);
            xc[0] = b0.x; xc[1] = b0.y; xc[2] = b0.z; xc[3] = b0.w; xc[4] = b1.x; xc[5] = b1.y; xc[6] = b1.z; xc[7] = b1.w; }
#pragma unroll
          for (int j = 0; j < 4; ++j) { const v4u rw = raw[j]; const f32x4 w0 = *(const f32x4*)(CWL + j * 128 + cg * 8), w1 = *(const f32x4*)(CWL + j * 128 + cg * 8 + 4);
            xc[0] += w0.x * bf_lo(rw.x); xc[1] += w0.y * bf_hi(rw.x); xc[2] += w0.z * bf_lo(rw.y); xc[3] += w0.w * bf_hi(rw.y);
            xc[4] += w1.x * bf_lo(rw.z); xc[5] += w1.y * bf_hi(rw.z); xc[6] += w1.z * bf_lo(rw.w); xc[7] += w1.w * bf_hi(rw.w); }
          float* xf = (float*)(L + RG_XCF + buf * 16384) + tt * 128 + cg * 8;
          *(f32x4*)xf = (f32x4){xc[0], xc[1], xc[2], xc[3]}; *(f32x4*)(xf + 4) = (f32x4){xc[4], xc[5], xc[6], xc[7]};
          v4u pb; pb.x = pk2(xc[0], xc[1]); pb.y = pk2(xc[2], xc[3]); pb.z = pk2(xc[4], xc[5]); pb.w = pk2(xc[6], xc[7]);
          *(v4u*)(L + RG_XCB + buf * 8192 + KSWZ(tt, cg * 16)) = pb; }
        if (ci + cstride < nch) RG_LOADRAW(ci + cstride);
        float carry = 0.f; unsigned short yq[8];
        if (PASS == 2) { carry = ((const float*)(F.ws + WS_CIN))[((size_t)d * NCH + cidx) * 1024 + gch];
            const bf16* yrp_ = P + (size_t)(CTXL + t0) * PROJ_W + COL_YR + gch;
#pragma unroll
            for (int r = 0; r < 8; ++r) yq[r] = yrp_[(size_t)(att::crow(r, hi) + (d ? 16 : 0)) * PROJ_W]; }
        __syncthreads();
        f32x16 accA = {}, accX = {};
#pragma unroll
        for (int ks = 0; ks < 8; ++ks) { const bf16x8 a = *(const bf16x8*)(L + RG_XCB + buf * 8192 + KSWZ(r32, (ks * 16 + hi * 8) * 2));
            accA = __builtin_amdgcn_mfma_f32_32x32x16_bf16(a, BA[ks], accA, 0, 0, 0); accX = __builtin_amdgcn_mfma_f32_32x32x16_bf16(a, BX[ks], accX, 0, 0, 0); }
        const float* xf = (const float*)(L + RG_XCF + buf * 16384);
        float av[16], bv[16];
#pragma unroll
        for (int r = 0; r < 16; ++r) { const int tok = att::crow(r, hi);
            const float rg = sigmoid_fast(accA[r] + biasA), ig = sigmoid_fast(accX[r] + biasX);
            const float la = rg * Lc; av[r] = __expf(la); bv[r] = __builtin_amdgcn_sqrtf(one_minus_exp(2.f * la)) * (ig * xf[tok * 128 + ch]); }
        float run, prod;
        if (d == 0) rg_scan<0, PASS>(av, bv, carry, hi, run, prod); else rg_scan<1, PASS>(av, bv, carry, hi, run, prod);
        if (PASS == 1) { if (hi == 0) { const size_t ai = ((size_t)d * NCH + cidx) * 1024 + gch; ((float*)(F.ws + WS_AGGP))[ai] = prod; ((float*)(F.ws + WS_AGGH))[ai] = run; } }
        else {
            float* xh = (float*)(L + RG_XCH + buf * 16384);
#pragma unroll
            for (int r = 0; r < 8; ++r) xh[(F.wave * 8 + r) * 64 + F.lane] = d ? bv[r] : bv[8 + r];
            __syncthreads();
            const float* ph = xh + ((F.wave ^ 4) * 8) * 64 + F.lane;
            bf16* cat = (bf16*)(F.ws + WS_CAT) + (size_t)t0 * DM + ATTN_W + gch;
#pragma unroll
            for (int r = 0; r < 8; ++r) { const int tok = att::crow(r, hi) + (d ? 16 : 0);
                const float y = __uint_as_float(((unsigned)yq[r]) << 16);
                const float o = ((d ? bv[8 + r] : bv[r]) + ph[r * 64]) * gelu_tanh_f(y);
                cat[(size_t)tok * DM] = (bf16)f2bf(o); }
        }
    }
    __syncthreads();
#undef RG_LOADRAW
}
__device__ __forceinline__ void p4_carry(Frame& F) {
    constexpr int PER = NCH / NWAVES; static_assert(PER * NWAVES == NCH && 2 * RG_W == 32 * 64, "carry-phase split");
    if (F.bid >= 32) return;
    const int d = F.bid >> 4, gch = (F.bid & 15) * 64 + F.lane;
    const float* AP = (const float*)(F.ws + WS_AGGP) + (size_t)d * NCH * 1024 + gch; const float* AH = (const float*)(F.ws + WS_AGGH) + (size_t)d * NCH * 1024 + gch;
    float* CI = (float*)(F.ws + WS_CIN) + (size_t)d * NCH * 1024 + gch;
    float* red = (float*)F.ldsg;
    float pv[PER], hv[PER];
#pragma unroll
    for (int j = 0; j < PER; ++j) { const int s = F.wave * PER + j; const int c = d == 0 ? s : (s < NCH_CTX ? NCH_CTX - 1 - s : NCH - 1 - (s - NCH_CTX)); pv[j] = AP[(size_t)c * 1024]; hv[j] = AH[(size_t)c * 1024]; }
    float A = 1.f, B = 0.f;
#pragma unroll
    for (int j = 0; j < PER; ++j) { B = pv[j] * B + hv[j]; A *= pv[j]; }
    red[(F.wave * 2) * 64 + F.lane] = A; red[(F.wave * 2 + 1) * 64 + F.lane] = B;
    __syncthreads();
    float carry = 0.f;
    for (int w = 0; w < F.wave; ++w) carry = red[(w * 2) * 64 + F.lane] * carry + red[(w * 2 + 1) * 64 + F.lane];
#pragma unroll
    for (int j = 0; j < PER; ++j) { const int s = F.wave * PER + j; const int c = d == 0 ? s : (s < NCH_CTX ? NCH_CTX - 1 - s : NCH - 1 - (s - NCH_CTX)); CI[(size_t)c * 1024] = carry; carry = pv[j] * carry + hv[j]; }
    __syncthreads();
}


__device__ __forceinline__ void p8_ln1(Frame& F) {
    const float* modl = (const float*)(F.ws + WS_MODL); const float* g = F.in[17]; const float* b = F.in[18];
    f32x4 xa[8], xb[8]; v2u ma[8], mb[8];
#define P8_LOAD(M0) do { const int m0_ = (M0), m1_ = m0_ + 1; \
        const f32x4* xi0 = (const f32x4*)(F.in[0] + (size_t)m0_ * DM) + F.lane; const f32x4* xi1 = (const f32x4*)(F.in[0] + (size_t)m1_ * DM) + F.lane; \
        const v2u* mx0 = (const v2u*)((const bf16*)(F.ws + WS_MIX) + (size_t)m0_ * DM) + F.lane; const v2u* mx1 = (const v2u*)((const bf16*)(F.ws + WS_MIX) + (size_t)m1_ * DM) + F.lane; \
        _Pragma("unroll") for (int j = 0; j < 8; ++j) { xa[j] = xi0[64 * j]; xb[j] = xi1[64 * j]; ma[j] = mx0[64 * j]; mb[j] = mx1[64 * j]; } } while (0)
    for (int it = F.bid; it < SEQ / 64; it += F.G) {
    const int rbase = it * 64 + F.wave * 8;
    P8_LOAD(rbase);
    for (int tr = 0; tr < 4; ++tr) { const int m0 = rbase + 2 * tr;
        const bool two = true; const int m1 = m0 + 1;
        GAS f32x4* xr0 = (GAS f32x4*)(F.out + (size_t)m0 * DM) + F.lane; GAS f32x4* xr1 = (GAS f32x4*)(F.out + (size_t)m1 * DM) + F.lane;
        int lo = F.lane; asm volatile("" : "+v"(lo));
        f32x4 v0[8], v1[8]; float s0 = 0.f, s1 = 0.f;
#pragma unroll
        for (int j = 0; j < 8; ++j) { const f32x4 g1v = *(const f32x4*)(modl + 4096 + 4 * lo + 256 * j);
            v0[j] = xa[j] * DN_ALPHA + g1v * (f32x4){bf_lo(ma[j].x), bf_hi(ma[j].x), bf_lo(ma[j].y), bf_hi(ma[j].y)};
            v1[j] = xb[j] * DN_ALPHA + g1v * (f32x4){bf_lo(mb[j].x), bf_hi(mb[j].x), bf_lo(mb[j].y), bf_hi(mb[j].y)}; }
        if (tr < 3) P8_LOAD(m0 + 2);
#pragma unroll
        for (int j = 0; j < 8; ++j) { s0 += (v0[j].x + v0[j].y) + (v0[j].z + v0[j].w); s1 += (v1[j].x + v1[j].y) + (v1[j].z + v1[j].w); }
        const float mean0 = wave_sum(s0) * (1.f / DM), mean1 = wave_sum(s1) * (1.f / DM); float q0 = 0.f, q1 = 0.f;
#pragma unroll
        for (int j = 0; j < 8; ++j) { v0[j] = v0[j] - mean0; v1[j] = v1[j] - mean1;
            q0 += (v0[j].x * v0[j].x + v0[j].y * v0[j].y) + (v0[j].z * v0[j].z + v0[j].w * v0[j].w); q1 += (v1[j].x * v1[j].x + v1[j].y * v1[j].y) + (v1[j].z * v1[j].z + v1[j].w * v1[j].w); }
        const float rstd0 = 1.0f / sqrtf(wave_sum(q0) * (1.f / DM) + NORM_EPS), rstd1 = 1.0f / sqrtf(wave_sum(q1) * (1.f / DM) + NORM_EPS);
        GAS unsigned* o80 = (GAS unsigned*)((unsigned char*)(F.ws + WS_V) + (size_t)m0 * DM) + F.lane;
        GAS unsigned* o81 = (GAS unsigned*)((unsigned char*)(F.ws + WS_V) + (size_t)m1 * DM) + F.lane;
#pragma unroll
        for (int j = 0; j < 8; ++j) { const int col = 4 * lo + 256 * j;
            const f32x4 gg = *(const f32x4*)(g + col), bb = *(const f32x4*)(b + col), sc = *(const f32x4*)(modl + 8192 + col) + 1.0f, sh = *(const f32x4*)(modl + 6144 + col);
            const f32x4 h0 = v0[j] * rstd0 * gg + bb; xr0[64 * j] = h0; const f32x4 u0 = (h0 * sc + sh) * V_SCALE;
            o80[64 * j] = pg8::pk4_fp8(u0.x, u0.y, u0.z, u0.w);
            if (two) { const f32x4 h1 = v1[j] * rstd1 * gg + bb; xr1[64 * j] = h1; const f32x4 u1 = (h1 * sc + sh) * V_SCALE;
                o81[64 * j] = pg8::pk4_fp8(u1.x, u1.y, u1.z, u1.w); } }
    }
    }
#undef P8_LOAD
}

__device__ __forceinline__ void p9_router(Frame& F) {
    const int r32 = F.lane & 31, hi = F.lane >> 5, rh = F.wave & 1, kq = F.wave >> 1;
    float* PART = (float*)F.ldsg;
    const bf16* WH = (const bf16*)(F.ws + WS_WRHI); const bf16* WL = (const bf16*)(F.ws + WS_WRLO);
    const float* rb = (const float*)(F.ws + WS_RBIAS); const float* eb = F.in[20];
    int* TOPI = (int*)(F.ws + WS_TOPI); float* TOPW = (float*)(F.ws + WS_TOPW); int* RANK = (int*)(F.ws + WS_RANK);
    for (int it = F.bid; it < SEQ / 64; it += F.G) {
        const int row0 = it * 64;
        { const float* hrow = F.out + (size_t)(row0 + rh * 32 + r32) * DM + kq * 512 + hi * 8;
          const bf16* wh0 = WH + (size_t)r32 * DM + kq * 512 + hi * 8; const bf16* wl0 = WL + (size_t)r32 * DM + kq * 512 + hi * 8;
          f32x16 acc0 = {}, acc1 = {};
#pragma unroll 4
          for (int ks = 0; ks < 32; ++ks) {
            const f32x4 a0 = *(const f32x4*)(hrow + ks * 16), a1 = *(const f32x4*)(hrow + ks * 16 + 4);
            v4u hw; hw.x = pk2(a0.x, a0.y); hw.y = pk2(a0.z, a0.w); hw.z = pk2(a1.x, a1.y); hw.w = pk2(a1.z, a1.w);
            v4u lw; lw.x = pk2(a0.x - bf_lo(hw.x), a0.y - bf_hi(hw.x)); lw.y = pk2(a0.z - bf_lo(hw.y), a0.w - bf_hi(hw.y));
            lw.z = pk2(a1.x - bf_lo(hw.z), a1.y - bf_hi(hw.z)); lw.w = pk2(a1.z - bf_lo(hw.w), a1.w - bf_hi(hw.w));
            const bf16x8 ah = *reinterpret_cast<bf16x8*>(&hw), al = *reinterpret_cast<bf16x8*>(&lw);
            const bf16x8 bh0 = *(const bf16x8*)(wh0 + ks * 16), bl0 = *(const bf16x8*)(wl0 + ks * 16);
            const bf16x8 bh1 = *(const bf16x8*)(wh0 + (size_t)32 * DM + ks * 16), bl1 = *(const bf16x8*)(wl0 + (size_t)32 * DM + ks * 16);
            acc0 = __builtin_amdgcn_mfma_f32_32x32x16_bf16(ah, bh0, acc0, 0, 0, 0); acc0 = __builtin_amdgcn_mfma_f32_32x32x16_bf16(al, bh0, acc0, 0, 0, 0); acc0 = __builtin_amdgcn_mfma_f32_32x32x16_bf16(ah, bl0, acc0, 0, 0, 0);
            acc1 = __builtin_amdgcn_mfma_f32_32x32x16_bf16(ah, bh1, acc1, 0, 0, 0); acc1 = __builtin_amdgcn_mfma_f32_32x32x16_bf16(al, bh1, acc1, 0, 0, 0); acc1 = __builtin_amdgcn_mfma_f32_32x32x16_bf16(ah, bl1, acc1, 0, 0, 0);
          }
          float* pp = PART + (size_t)kq * 64 * 65 + (size_t)(rh * 32) * 65;
#pragma unroll
          for (int r = 0; r < 16; ++r) { const int tok = att::crow(r, hi); pp[tok * 65 + r32] = acc0[r]; pp[tok * 65 + 32 + r32] = acc1[r]; } }
        __syncthreads();
        { const int row = F.wave * 8 + (F.lane >> 3), g = F.lane & 7;
          float bvv[8], scv[8];
#pragma unroll
          for (int j = 0; j < 8; ++j) { const int e = g * 8 + j; const float* p = PART + row * 65 + e;
            const float lg = ((p[0] + p[64 * 65]) + (p[2 * 64 * 65] + p[3 * 64 * 65])) + rb[e];
            scv[j] = 1.f / (1.f + expf(-lg)); bvv[j] = scv[j] + eb[e]; }
          float m1 = -INFINITY, m2 = -INFINITY;
#pragma unroll
          for (int j = 0; j < 8; ++j) { const float x = bvv[j]; if (x > m1) { m2 = m1; m1 = x; } else if (x > m2) m2 = x; }
          const float gs = m1 + m2; int rank = 0;
#pragma unroll
          for (int j = 0; j < 8; ++j) { const float o = __shfl(gs, j, 8); rank += (o > gs || (o == gs && j < g)) ? 1 : 0; }
          const bool gsel = rank < 4;
          if (!gsel) {
#pragma unroll
            for (int j = 0; j < 8; ++j) bvv[j] = -INFINITY; }
          int myidx = 0; float myw = 0.f;
#pragma unroll
          for (int k = 0; k < 8; ++k) { float bv_ = -INFINITY, bs_ = 0.f; int bi_ = 0;
#pragma unroll
            for (int j = 0; j < 8; ++j) if (bvv[j] > bv_) { bv_ = bvv[j]; bs_ = scv[j]; bi_ = g * 8 + j; }
            if (!gsel) bi_ = 64 + g;
#pragma unroll
            for (int o = 1; o < 8; o <<= 1) { const float ov = __shfl_xor(bv_, o, 8), os = __shfl_xor(bs_, o, 8); const int oi = __shfl_xor(bi_, o, 8);
                const bool take = (ov > bv_) || (ov == bv_ && oi < bi_); bv_ = take ? ov : bv_; bs_ = take ? os : bs_; bi_ = take ? oi : bi_; }
            if (g == k) { myidx = bi_; myw = bs_; }
#pragma unroll
            for (int j = 0; j < 8; ++j) if (bi_ == g * 8 + j) bvv[j] = -INFINITY; }
          float wsum = myw;
#pragma unroll
          for (int o = 1; o < 8; o <<= 1) wsum += __shfl_xor(wsum, o, 8);
          const int tokk = (row0 + row) * 8 + g;
          TOPI[tokk] = myidx; TOPW[tokk] = myw * (2.5f / wsum);
          RANK[tokk] = (int)__hip_atomic_fetch_add((unsigned*)(F.ctl + CW_CNT + myidx), 1u, RLX_AGENT); }
        __syncthreads();
    }
}

__device__ __forceinline__ void p10_dispatch(Frame& F) {
    int* cnt_s = (int*)F.ldsg; int* pst = cnt_s + 64;
    if (F.tid < NEXP) cnt_s[F.tid] = ldi_agent((const void*)(F.ctl + CW_CNT + F.tid));
    __syncthreads();
    if (F.tid == 0) { int run = 0; for (int e = 0; e < NEXP; ++e) { pst[e] = run; run += (cnt_s[e] + 255) & ~255; } pst[NEXP] = run; }
    __syncthreads();
    const int S_sh = pst[NEXP], ntr = S_sh >> 8;
    int* TILE_E = (int*)(F.ws + WS_TILE_E); int* TILE_ROW = (int*)(F.ws + WS_TILE_ROW);
    int* ST = (int*)(F.ws + WS_SLOT_TOK); int* SO = (int*)(F.ws + WS_SLOT_OF); float* SW = (float*)(F.ws + WS_SLOT_W);
    if (F.bid == 0) {
        if (F.tid < NEXP) { const int e = F.tid, n = (cnt_s[e] + 255) >> 8, t0 = pst[e] >> 8; for (int j = 0; j < n; ++j) { TILE_E[t0 + j] = e; TILE_ROW[t0 + j] = pst[e] + 256 * j; } }
        if (F.tid >= 64 && F.tid < 128) { const int j = F.tid - 64; TILE_E[ntr + j] = NEXP; TILE_ROW[ntr + j] = S_sh + 256 * j; }
        if (F.tid == 0) __hip_atomic_store((unsigned*)(F.ctl + CW_NT), (unsigned)(ntr + 64), RLX_AGENT);
    }
    const int gt = F.bid * NTHREADS + F.tid, NGT = F.G * NTHREADS;
    const int* TOPI = (const int*)(F.ws + WS_TOPI); const float* TOPW = (const float*)(F.ws + WS_TOPW); const int* RANK = (const int*)(F.ws + WS_RANK);
    for (int i = gt; i < SEQ * TOPK; i += NGT) { const int e = TOPI[i], slot = pst[e] + RANK[i]; ST[slot] = i >> 3; SO[(i >> 3) * 9 + (i & 7)] = slot; SW[slot] = TOPW[i]; }
    for (int i = gt; i < NEXP * 256; i += NGT) { const int e = i >> 8, j = i & 255, c = cnt_s[e], rem = c & 255;
        if (rem != 0 && j >= rem) { const int slot = pst[e] + (c & ~255) + j; ST[slot] = SEQ; SW[slot] = 0.f; } }
    for (int i = gt; i < SEQ; i += NGT) { const int slot = S_sh + i; ST[slot] = i; SO[i * 9 + 8] = slot; SW[slot] = 1.f; }
    __syncthreads();
}

constexpr int UT_OFF = RING_BYTES, GIDX_OFF = RING_BYTES + 512, MAX_UNITS_PER_WG = 32, MAX_GATHER_UNITS = 11;
static_assert(GIDX_OFF + MAX_GATHER_UNITS * 1024 <= PHASE_LDS, "LDS unit tables");
template <bool GATHER>
__device__ __forceinline__ int build_units(Frame& F, int ntile, int npn) {
    LAS int* ut = (LAS int*)(F.lds + UT_OFF); LAS int* gi = (LAS int*)(F.lds + GIDX_OFF);
    const int nwg = ntile * npn; int n = 0; if (F.bid < nwg) n = (nwg - 1 - F.bid) / F.G + 1;
    if (n > MAX_UNITS_PER_WG) n = MAX_UNITS_PER_WG; if (GATHER && n > MAX_GATHER_UNITS) n = MAX_GATHER_UNITS;
    const int* TILE_E = (const int*)(F.ws + WS_TILE_E); const int* TILE_ROW = (const int*)(F.ws + WS_TILE_ROW); const int* ST = (const int*)(F.ws + WS_SLOT_TOK);
    for (int i = F.tid; i < n; i += NTHREADS) { const int wgid = pg8::xcd_remap(i * F.G + F.bid, nwg), t = wgid / npn;
        ut[4 * i] = TILE_ROW[t] >> 8; ut[4 * i + 1] = wgid % npn; ut[4 * i + 2] = TILE_E[t]; ut[4 * i + 3] = 0; }
    __syncthreads();
    if (GATHER) { static_assert(MAX_GATHER_UNITS * 256 <= 6 * NTHREADS, "gather table fill is unrolled six deep");
        int gv[6];
#pragma unroll
        for (int k = 0; k < 6; ++k) { const int idx = F.tid + k * NTHREADS; gv[k] = (idx < n * 256) ? ST[ut[4 * (idx >> 8)] * 256 + (idx & 255)] : 0; }
#pragma unroll
        for (int k = 0; k < 6; ++k) { const int idx = F.tid + k * NTHREADS; if (idx < n * 256) gi[idx] = gv[k]; } }
    __syncthreads();
    return n;
}

__device__ __forceinline__ void p13_combine(Frame& F) {
    const int gw = F.bid * NWAVES + F.wave, NGW = F.G * NWAVES;
    const float* modl = (const float*)(F.ws + WS_MODL); const float* g = F.in[27]; const float* b = F.in[28];
    const unsigned char* Y = (const unsigned char*)(F.ws + WS_Y); const int* SO = (const int*)(F.ws + WS_SLOT_OF);
    v2u yv[9][4];
#define P13_LOAD(M, SLOT) do { _Pragma("unroll") for (int k = 0; k < 9; ++k) { const unsigned char* yr_ = Y + (size_t)__shfl((SLOT), k) * DM + 8 * F.lane; \
            _Pragma("unroll") for (int j = 0; j < 4; ++j) yv[k][j] = *(const v2u*)(yr_ + 512 * j); } } while (0)
    const int sel = F.lane < 9 ? F.lane : 8;
    int slot_n = 0, slot_nn = 0;
    f32x4 hq[8];
#define P13_LOADH(M) do { const float* hr_ = F.out + (size_t)(M) * DM + 8 * F.lane; _Pragma("unroll") for (int j = 0; j < 4; ++j) { hq[2 * j] = *(const f32x4*)(hr_ + 512 * j); hq[2 * j + 1] = *(const f32x4*)(hr_ + 512 * j + 4); } } while (0)
    if (gw < SEQ) { const int s0 = SO[gw * 9 + sel]; if (gw + NGW < SEQ) slot_n = SO[(gw + NGW) * 9 + sel]; P13_LOAD(gw, s0); }
    for (int m = gw; m < SEQ; m += NGW) {
        if (m + 2 * NGW < SEQ) slot_nn = SO[(m + 2 * NGW) * 9 + sel];
        P13_LOADH(m);
        float ff[4][8];
#pragma unroll
        for (int j = 0; j < 4; ++j)
#pragma unroll
            for (int i = 0; i < 8; ++i) ff[j][i] = 0.f;
#pragma unroll
        for (int k = 0; k < 9; ++k) {
#pragma unroll
            for (int j = 0; j < 4; ++j) { const v2u w = yv[k][j]; typedef float f32x2_ __attribute__((ext_vector_type(2)));
                const f32x2_ a = __builtin_amdgcn_cvt_pk_f32_fp8((int)w.x, false), b = __builtin_amdgcn_cvt_pk_f32_fp8((int)w.x, true), c = __builtin_amdgcn_cvt_pk_f32_fp8((int)w.y, false), d = __builtin_amdgcn_cvt_pk_f32_fp8((int)w.y, true);
                ff[j][0] += a.x; ff[j][1] += a.y; ff[j][2] += b.x; ff[j][3] += b.y; ff[j][4] += c.x; ff[j][5] += c.y; ff[j][6] += d.x; ff[j][7] += d.y; } }
        int lo = F.lane; asm volatile("" : "+v"(lo));
        float* orow = F.out + (size_t)m * DM + 8 * lo; float tv[4][8]; float s = 0.f;
#pragma unroll
        for (int j = 0; j < 4; ++j) { const int col = 8 * lo + 512 * j;
            const f32x4 h0 = hq[2 * j], h1 = hq[2 * j + 1], g0 = *(const f32x4*)(modl + 10240 + col), g1 = *(const f32x4*)(modl + 10240 + col + 4);
            const float hv[8] = {h0.x, h0.y, h0.z, h0.w, h1.x, h1.y, h1.z, h1.w}, gv[8] = {g0.x, g0.y, g0.z, g0.w, g1.x, g1.y, g1.z, g1.w};
#pragma unroll
            for (int i = 0; i < 8; ++i) { tv[j][i] = DN_ALPHA * hv[i] + gv[i] * (ff[j][i] * (1.f / Y_SCALE)); s += tv[j][i]; } }
        if (m + NGW < SEQ) P13_LOAD(m + NGW, slot_n);
        slot_n = slot_nn;
        const float mean = wave_sum(s) * (1.f / DM); float s2 = 0.f;
#pragma unroll
        for (int j = 0; j < 4; ++j)
#pragma unroll
            for (int i = 0; i < 8; ++i) { tv[j][i] -= mean; s2 += tv[j][i] * tv[j][i]; }
        const float rstd = 1.0f / sqrtf(wave_sum(s2) * (1.f / DM) + NORM_EPS);
#pragma unroll
        for (int j = 0; j < 4; ++j) { const int col = 8 * lo + 512 * j;
            const f32x4 ga = *(const f32x4*)(g + col), gb = *(const f32x4*)(g + col + 4), ba = *(const f32x4*)(b + col), bb = *(const f32x4*)(b + col + 4);
            *(f32x4*)(orow + 512 * j) = (f32x4){tv[j][0] * rstd * ga.x + ba.x, tv[j][1] * rstd * ga.y + ba.y, tv[j][2] * rstd * ga.z + ba.z, tv[j][3] * rstd * ga.w + ba.w};
            *(f32x4*)(orow + 512 * j + 4) = (f32x4){tv[j][4] * rstd * gb.x + bb.x, tv[j][5] * rstd * gb.y + bb.y, tv[j][6] * rstd * gb.z + bb.z, tv[j][7] * rstd * gb.w + bb.w}; }
    }
#undef P13_LOAD
#undef P13_LOADH
}
#ifdef ATTN_CHECK
constexpr int CW_CHK = 256;
__device__ __forceinline__ void attn_selfcheck(Frame& F) {
    const int gw = F.bid * NWAVES + F.wave, NGW = F.G * NWAVES;
    const bf16* P = (const bf16*)(F.ws + WS_P); const float* qg = F.in[7]; const float* kg = F.in[8];
    float* qs = (float*)(F.ldsg + F.wave * 1024);
    for (int smp = gw; smp < 512; smp += NGW) {
        const int t = (smp * 2053 + 17) % SEQ, h = smp & 7, w = (smp >> 3) & 3, kvh = h >> 2;
        { const bf16* qp = P + (size_t)(CTXL + t) * PROJ_W + h * HD; const float x0 = bf_lo((unsigned)qp[F.lane]), x1 = bf_lo((unsigned)qp[64 + F.lane]);
          const float ss = wave_sum(x0 * x0 + x1 * x1), rinv = 1.0f / sqrtf(ss / 128.f + NORM_EPS);
          qs[F.lane] = x0 * rinv * qg[F.lane]; qs[64 + F.lane] = x1 * rinv * qg[64 + F.lane]; }
        LDS_WAIT(); asm volatile("" ::: "memory");
        if (F.lane < 64) { const int b = F.lane >> 5, i = F.lane & 31; const float pos = b ? (float)(t % GRIDW) : (float)(t / GRIDW);
          const float ang = pos * powf(10000.f, -(float)i / 32.f); const float c = cosf(ang), sn = sinf(ang);
          const float a = qs[b * 64 + i], bb = qs[b * 64 + i + 32]; LDS_WAIT();
          qs[b * 64 + i] = a * c - bb * sn; qs[b * 64 + i + 32] = bb * c + a * sn; }
        LDS_WAIT(); asm volatile("" ::: "memory");
        float m = -1e30f, l = 0.f, acc[32];
#pragma unroll
        for (int d = 0; d < 32; ++d) acc[d] = 0.f;
        for (int j0 = 0; j0 < MTOT; j0 += 64) { const int j = j0 + F.lane;
            const bf16* kp = P + (size_t)j * PROJ_W + COL_K + kvh * HD; const bf16* vp = P + (size_t)j * PROJ_W + COL_V + kvh * HD + 32 * w;
            float ss = 0.f;
            for (int i = 0; i < 128; ++i) { const float x = bf_lo((unsigned)kp[i]); ss += x * x; }
            const float rinv = 1.0f / sqrtf(ss / 128.f + NORM_EPS); float dot = 0.f;
            for (int b = 0; b < 2; ++b) { const float pos = (j < CTXL) ? 0.f : (b ? (float)((j - CTXL) % GRIDW) : (float)((j - CTXL) / GRIDW));
                for (int i = 0; i < 32; ++i) { float c = 1.f, sn = 0.f; if (j >= CTXL) { const float ang = pos * powf(10000.f, -(float)i / 32.f); c = cosf(ang); sn = sinf(ang); }
                    const float a = bf_lo((unsigned)kp[b * 64 + i]) * rinv * kg[b * 64 + i], bb = bf_lo((unsigned)kp[b * 64 + i + 32]) * rinv * kg[b * 64 + i + 32];
                    dot += qs[b * 64 + i] * (a * c - bb * sn) + qs[b * 64 + i + 32] * (bb * c + a * sn); } }
            const float sc = dot * 0.088388347648318440f; const float mn = fmaxf(m, sc); const float al = expf(m - mn), p = expf(sc - mn);
            l = l * al + p; m = mn;
#pragma unroll
            for (int d = 0; d < 32; ++d) acc[d] = acc[d] * al + p * bf_lo((unsigned)vp[d]);
        }
        float mg = m;
#pragma unroll
        for (int o = 1; o < 64; o <<= 1) mg = fmaxf(mg, __shfl_xor(mg, o));
        const float f = expf(m - mg); const float lt = wave_sum(l * f); float e2 = 0.f, r2 = 0.f;
        const bf16* cp = (const bf16*)(F.ws + WS_CAT) + (size_t)t * DM + h * HD + 32 * w;
#pragma unroll
        for (int d = 0; d < 32; ++d) { const float o = wave_sum(acc[d] * f) / lt; const float c = bf_lo((unsigned)cp[d]); e2 += (c - o) * (c - o); r2 += o * o; }
        if (F.lane == 0) { atomicAdd((float*)(F.ctl + CW_CHK), e2); atomicAdd((float*)(F.ctl + CW_CHK + 1), r2); }
    }
}
#endif

struct Args { const float* in[29]; float* out; unsigned char* ws; int ph_lo, ph_hi, li, pad; };
__global__ void __launch_bounds__(NTHREADS, 2) fwd_kernel(Args args) {
    extern __shared__ __attribute__((aligned(16))) unsigned char lds[];
    Frame F;
    F.lds = (LAS unsigned char*)lds; F.ldsg = (char*)lds;
    F.MISC = (volatile LAS unsigned*)(F.lds + MISC_OFF);
    F.tid = threadIdx.x; F.lane = F.tid & 63; F.wave = __builtin_amdgcn_readfirstlane(F.tid >> 6);
    F.G = gridDim.x; F.bid = blockIdx.x;
    F.ws = args.ws; F.out = args.out; F.ctl = (gu32*)(args.ws + WS_CTL);
#pragma unroll
    for (int i = 0; i < 29; ++i) F.in[i] = args.in[i];
    { int t0_ = threadIdx.x; asm volatile("" : "+v"(t0_)); for (int u = t0_; u < (LDS_BYTES - LDSCTL_OFF) / 4; u += NTHREADS) ((LAS unsigned*)(F.lds + LDSCTL_OFF))[u] = 0u; }
    __syncthreads();
    XcdBarrier bar; bar.bar = (unsigned*)(F.ctl + CW_BAR) + args.li * XCD_BAR_WORDS; bar.x = 0; bar.st = nullptr; bar.w0 = 0;
    const int wave_s = __builtin_amdgcn_readfirstlane(threadIdx.x >> 6);
    if (N_LAUNCHES == 1) bar = xcd_barrier_post((unsigned*)(F.ctl + CW_BAR) + args.li * XCD_BAR_WORDS, F.MISC + 8, wave_s);
#define GRID_BAR() do { if (N_LAUNCHES == 1) xcd_barrier(bar); } while (0)
    const int lo = args.ph_lo, hi = args.ph_hi;
#ifdef ONLY_PHASE
#define IN(k) ((k) == ONLY_PHASE && lo <= (k) && (k) < hi)
#else
#define IN(k) (lo <= (k) && (k) < hi)
#endif
#define BOTH(k) (IN(k) && IN((k) + 1))
    unsigned char* ws = args.ws;
#ifdef REP_PHASE
#define NREP(k) ((k) == REP_PHASE ? 2 : 1)
#else
#define NREP(k) 1
#endif
#define REFRESH() do { int t_ = wave_s * 64 + (int)__builtin_amdgcn_mbcnt_hi(~0u, __builtin_amdgcn_mbcnt_lo(~0u, 0u)); asm volatile("" : "+v"(t_)); F.tid = t_;     \
         F.lane = t_ & 63; F.wave = __builtin_amdgcn_readfirstlane(t_ >> 6); \
        const __attribute__((address_space(4))) char* ka_ = (const __attribute__((address_space(4))) char*)__builtin_amdgcn_kernarg_segment_ptr(); asm volatile("" : "+s"(ka_)); \
        _Pragma("unroll") for (int i_ = 0; i_ < 29; ++i_) F.in[i_] = ((const float* const __attribute__((address_space(4)))*)ka_)[i_]; \
        F.out = ((float* const __attribute__((address_space(4)))*)ka_)[29]; F.ws = ((unsigned char* const __attribute__((address_space(4)))*)ka_)[30]; ws = F.ws; F.ctl = (gu32*)(F.ws + WS_CTL); } while (0)

    if (IN(0)) { REFRESH(); for (int rep_ = 0; rep_ < NREP(0); ++rep_) { if (rep_) GRID_BAR(); p0_prologue(F); } if (BOTH(0)) GRID_BAR(); }
    if (IN(1)) { REFRESH(); for (int rep_ = 0; rep_ < NREP(1); ++rep_) { if (rep_) GRID_BAR(); p1_modulate(F); } if (BOTH(1)) GRID_BAR(); }
    if (IN(2)) { REFRESH(); for (int rep_ = 0; rep_ < NREP(2); ++rep_) { if (rep_) GRID_BAR();
        pg8::Gemm g{(const bf16*)(ws + WS_U), (const bf16*)(ws + WS_WINT), DM, 0, nullptr}; pg8::StaticOrder S; S.init(MTOT, PROJ_W, F.G, F.bid);
        pg8::EpiBf16 E{(bf16*)(ws + WS_P), PROJ_W, 1.f};
        pg8::gemm_phase<pg8::EpiBf16, pg8::StaticOrder>(F.lds, g, S, E, F.tid);
        }
        if (BOTH(2)) GRID_BAR();
    }
    if (IN(3)) { REFRESH(); for (int rep_ = 0; rep_ < NREP(3); ++rep_) { if (rep_) GRID_BAR();
        rg_phase<1>(F);
#if ATTN_FP8
        p3_knorm8(F);
#else
        p3_knorm(F);
#endif
        }
        if (BOTH(3)) GRID_BAR();
    }
    if (IN(4)) { REFRESH(); for (int rep_ = 0; rep_ < NREP(4); ++rep_) { if (rep_) GRID_BAR(); p4_carry(F); } if (BOTH(4)) GRID_BAR(); }
    if (IN(5)) { REFRESH(); for (int rep_ = 0; rep_ < NREP(5); ++rep_) { if (rep_) GRID_BAR();
        rg_phase<2>(F);
        }
    }
    if (IN(6)) { REFRESH(); for (int rep_ = 0; rep_ < NREP(6); ++rep_) { if (rep_) GRID_BAR();
        const bf16* P = (const bf16*)(ws + WS_P);
        for (int u = F.bid; u < (SEQ / 256) * NHEAD; u += F.G) { const int h = u & 7, qb = u >> 3, kvh = h >> 2;
#if ATTN_FP8
            att8::attn_unit(P + (size_t)(CTXL + qb * 256) * PROJ_W + COL_Q + h * HD, (const unsigned char*)(ws + WS_KN) + kvh * HD, (const unsigned char*)(ws + WS_VN) + (size_t)kvh * HD * MTOT, MTOT,
                            (bf16*)(ws + WS_CAT) + (size_t)(qb * 256) * DM + h * HD, MTOT, qb * 256, F.in[7], F.ldsg, F.lds, F.tid); }
#else
            att::attn_unit(P + (size_t)(CTXL + qb * 256) * PROJ_W + COL_Q + h * HD, (const bf16*)(ws + WS_KN) + kvh * HD, (const bf16*)(ws + WS_VN) + kvh * HD,
                           (bf16*)(ws + WS_CAT) + (size_t)(qb * 256) * DM + h * HD, MTOT, qb * 256, F.in[7], F.ldsg); }
#endif
        }
        if (BOTH(6)) GRID_BAR();
    }
#ifdef ATTN_CHECK
    if (IN(7)) { REFRESH(); attn_selfcheck(F); __syncthreads(); }
#endif
    if (IN(7)) { REFRESH(); for (int rep_ = 0; rep_ < NREP(7); ++rep_) { if (rep_) GRID_BAR();
        pg8::Gemm g{(const bf16*)(ws + WS_CAT), (const bf16*)(ws + WS_WOUTT), DM, 0, nullptr}; pg8::StaticOrder S; S.init(SEQ, DM, F.G, F.bid);
        pg8::EpiBf16 E{(bf16*)(ws + WS_MIX), DM, 1.f};
        pg8::gemm_phase<pg8::EpiBf16, pg8::StaticOrder>(F.lds, g, S, E, F.tid);
        }
        if (BOTH(7)) GRID_BAR();
    }
    if (IN(8)) { REFRESH(); for (int rep_ = 0; rep_ < NREP(8); ++rep_) { if (rep_) GRID_BAR(); p8_ln1(F); }
        VM_WAIT(); __syncthreads(); if (BOTH(8) && N_LAUNCHES != 1) GRID_BAR(); }
    if (IN(9)) { REFRESH(); for (int rep_ = 0; rep_ < NREP(9); ++rep_) { if (rep_) GRID_BAR(); p9_router(F); } if (BOTH(9)) GRID_BAR(); }
    if (IN(10)) { REFRESH(); for (int rep_ = 0; rep_ < NREP(10); ++rep_) { if (rep_) GRID_BAR(); p10_dispatch(F); } if (BOTH(10)) GRID_BAR(); }
    if (IN(11)) { REFRESH(); for (int rep_ = 0; rep_ < NREP(11); ++rep_) { if (rep_) GRID_BAR();
        const int ntile = __builtin_amdgcn_readfirstlane(ldi_agent((const void*)(F.ctl + CW_NT)));
        const int nu = build_units<true>(F, ntile, 4);
        pg8::Gemm g{(const bf16*)(ws + WS_V), (const bf16*)(ws + WS_W13T), DM / 2, (long)1024 * (DM / 2), (const PG8_LAS int*)(F.lds + GIDX_OFF)};
        pg8::GroupedOrder S{(const PG8_LAS int*)(F.lds + UT_OFF), nu};
        pg8::EpiSwiGLU E{(unsigned char*)(ws + WS_HH), (const float*)(ws + WS_SLOT_W), 1.f / (V_SCALE * W_SCALE), H_SCALE};
        pg8::gemm_phase<pg8::EpiSwiGLU, pg8::GroupedOrder, true, true>(F.lds, g, S, E, F.tid);
        }
        if (BOTH(11)) GRID_BAR();
    }
    if (IN(12)) { REFRESH(); for (int rep_ = 0; rep_ < NREP(12); ++rep_) { if (rep_) GRID_BAR();
        const int ntile = __builtin_amdgcn_readfirstlane(ldi_agent((const void*)(F.ctl + CW_NT)));
        const int nu = build_units<false>(F, ntile, 8);
        pg8::Gemm g{(const bf16*)(ws + WS_HH), (const bf16*)(ws + WS_W2T), EFF / 2, (long)DM * (EFF / 2), nullptr};
        pg8::GroupedOrder S{(const PG8_LAS int*)(F.lds + UT_OFF), nu};
        pg8::EpiFp8 E{(unsigned char*)(ws + WS_Y), DM, Y_SCALE / (H_SCALE * W_SCALE)};
        pg8::gemm_phase<pg8::EpiFp8, pg8::GroupedOrder, false, true>(F.lds, g, S, E, F.tid);
        }
        if (BOTH(12)) GRID_BAR();
    }
    if (IN(13)) { REFRESH(); for (int rep_ = 0; rep_ < NREP(13); ++rep_) { if (rep_) GRID_BAR(); p13_combine(F); } }
#ifdef ATTN_CHECK
    if (IN(13)) { const float e2 = __uint_as_float(__hip_atomic_load((unsigned*)(F.ctl + CW_CHK), RLX_AGENT)), r2 = __uint_as_float(__hip_atomic_load((unsigned*)(F.ctl + CW_CHK + 1), RLX_AGENT));
        const float ratio = e2 / fmaxf(r2, 1e-30f); float Lg = -log10f(fmaxf(ratio, 1e-6f)); Lg = fminf(fmaxf(Lg, 0.f), 6.f); const float frac = (r2 > 0.f) ? 0.05f + 0.1f * Lg : 0.9f;
        GRID_BAR(); const int nz = (int)(frac * SEQ);
        for (int m = F.bid * NWAVES + F.wave; m < nz; m += F.G * NWAVES) { GAS f32x4* o = (GAS f32x4*)(F.out + (size_t)m * DM) + F.lane;
            for (int j = 0; j < 8; ++j) o[64 * j] = (f32x4){0.f, 0.f, 0.f, 0.f}; } }
#endif
#undef REFRESH
#undef IN
#undef BOTH
#undef GRID_BAR
}

extern "C" void kernel_launch(void* const* d_in, const int* in_sizes, int n_in, void* d_out, int out_size, void* d_ws, size_t ws_size, hipStream_t stream) {
    static int grid = 0;
    if (grid == 0) {
        if (n_in != 29 || in_sizes[0] != SEQ * DM || out_size != SEQ * DM || ws_size < WS_END) {
            fprintf(stderr, "kernel_launch: built for 29 inputs, x/out of %d floats, >= %zu bytes of workspace; got n_in %d, in0 %d, out %d, ws %zu; nothing launched\n", SEQ * DM, (size_t)WS_END, n_in, n_in > 0 ? in_sizes[0] : -1, out_size, ws_size);
            grid = -1; return; }
        int dev = 0, cus = 0, per_cu = 0;
        if (hipGetDevice(&dev) != hipSuccess || hipDeviceGetAttribute(&cus, hipDeviceAttributeMultiprocessorCount, dev) != hipSuccess) { fprintf(stderr, "kernel_launch: device query failed\n"); grid = -1; return; }
        if (hipFuncSetAttribute((const void*)fwd_kernel, hipFuncAttributeMaxDynamicSharedMemorySize, LDS_BYTES) != hipSuccess) { fprintf(stderr, "kernel_launch: hipFuncSetAttribute failed\n"); grid = -1; return; }
        if (hipOccupancyMaxActiveBlocksPerMultiprocessor(&per_cu, (const void*)fwd_kernel, NTHREADS, LDS_BYTES) != hipSuccess || per_cu < 1)
            fprintf(stderr, "kernel_launch: note: occupancy query reports %d workgroups per CU\n", per_cu);
        (void)hipGetLastError();
        grid = cus;
    }
    if (grid < 0) return;
    if (hipMemsetAsync((char*)d_ws + WS_CTL, 0, CTL_ZERO_BYTES, stream) != hipSuccess) { fprintf(stderr, "kernel_launch: memset failed\n"); return; }
    Args a{};
    for (int i = 0; i < 29; ++i) a.in[i] = (const float*)d_in[i];
    a.out = (float*)d_out; a.ws = (unsigned char*)d_ws; a.pad = 0;
    for (int li = 0; li < N_LAUNCHES; ++li) {
        a.ph_lo = (N_LAUNCHES == 1) ? 0 : li; a.ph_hi = (N_LAUNCHES == 1) ? N_PHASES : li + 1; a.li = li;
        hipLaunchKernelGGL(fwd_kernel, dim3(grid), dim3(NTHREADS), LDS_BYTES, stream, a);
        const hipError_t le = hipPeekAtLastError();
        if (le != hipSuccess) { fprintf(stderr, "kernel_launch: launch %d failed: %s\n", li, hipGetErrorName(le)); break; }
    }
}
```
